# Optimizing an MI355X kernel written in HIP

```python
import math
import jax, jax.numpy as jnp
from jax import lax
import numpy as np

D_MODEL = 2048
BATCH = 4
SEQ = 4096
DEPTH = 2

HEAD_DIM = 128
N_SB_HEADS = D_MODEL // (2 * HEAD_DIM)
N_DIFF_HEADS = D_MODEL // (4 * HEAD_DIM)
SB_WIDTH = N_SB_HEADS * HEAD_DIM
DIFF_WIDTH = N_DIFF_HEADS * 2 * HEAD_DIM
MIX_WIDTH = SB_WIDTH + DIFF_WIDTH
IN_WIDTH = 3 * SB_WIDTH + 3 * DIFF_WIDTH
D_FF = 4 * D_MODEL
N_BUCKETS = 32
MAX_DISTANCE = 128
Q_BLOCK = 128
LN_EPS = 1e-5
RMS_EPS = 1e-5
NEG_BIG = -1e30
ALPHA = (2 * DEPTH) ** 0.25
INIT_BETA = (8 * DEPTH) ** -0.25

kernel_name = "hybrid_sb_diff_attn_deepnorm"


def layernorm(x, g, b):
    xf = x.astype(jnp.float32)
    mu = jnp.mean(xf, axis=-1, keepdims=True)
    var = jnp.mean(jnp.square(xf - mu), axis=-1, keepdims=True)
    y = (xf - mu) * lax.rsqrt(var + LN_EPS) * g.astype(jnp.float32) + b.astype(jnp.float32)
    return y.astype(x.dtype)


def rmsnorm(x, g):
    xf = x.astype(jnp.float32)
    y = xf * lax.rsqrt(jnp.mean(jnp.square(xf), axis=-1, keepdims=True) + RMS_EPS)
    return y * g.astype(jnp.float32)


def t5_causal_bucket(dist):
    n = jnp.maximum(dist, 0)
    max_exact = N_BUCKETS // 2
    nf = jnp.maximum(n, 1).astype(jnp.float32)
    large = max_exact + (jnp.log(nf / max_exact) / math.log(MAX_DISTANCE / max_exact)
                         * (N_BUCKETS - max_exact)).astype(jnp.int32)
    large = jnp.minimum(large, N_BUCKETS - 1)
    return jnp.where(n < max_exact, n, large)


def stick_breaking_attention(q, k, v):
    B, H, S, d = q.shape
    nb = S // Q_BLOCK
    scale = 1.0 / math.sqrt(d)
    kf = k.astype(jnp.float32)
    vf = v.astype(jnp.float32)
    q_blocks = jnp.moveaxis(q.reshape(B, H, nb, Q_BLOCK, d), 2, 0)
    s_pos = jnp.arange(S)

    def block(args):
        i, qb = args
        z = jnp.einsum('bhqd,bhkd->bhqk', qb.astype(jnp.float32), kf) * scale
        t_pos = i * Q_BLOCK + jnp.arange(Q_BLOCK)
        causal = s_pos[None, :] < t_pos[:, None]
        log_fail = jnp.where(causal, jax.nn.log_sigmoid(-z), 0.0)
        suffix = lax.cumsum(log_fail, axis=3, reverse=True) - log_fail
        w = jnp.where(causal, jnp.exp(jax.nn.log_sigmoid(z) + suffix), 0.0)
        return jnp.einsum('bhqk,bhkd->bhqd', w, vf)

    out = lax.map(block, (jnp.arange(nb), q_blocks))
    out = jnp.moveaxis(out, 0, 2).reshape(B, H, S, d)
    return jnp.transpose(out, (0, 2, 1, 3))


def differential_attention(q, k, v, lam, rel_bias):
    B, H, _, S, d = q.shape
    nb = S // Q_BLOCK
    scale = 1.0 / math.sqrt(d)
    kf = k.astype(jnp.float32)
    vf = v.astype(jnp.float32)
    q_blocks = jnp.moveaxis(q.reshape(B, H, 2, nb, Q_BLOCK, d), 3, 0)
    s_pos = jnp.arange(S)
    table = rel_bias.astype(jnp.float32)

    def block(args):
        i, qb = args
        t_pos = i * Q_BLOCK + jnp.arange(Q_BLOCK)
        dist = t_pos[:, None] - s_pos[None, :]
        bias = jnp.transpose(table[t5_causal_bucket(dist)], (2, 0, 1))
        logits = jnp.einsum('bhmqd,bhmkd->bhmqk', qb.astype(jnp.float32), kf) * scale
        logits = logits + bias[None, :, None]
        logits = jnp.where((dist >= 0)[None, None, None], logits, NEG_BIG)
        p = jax.nn.softmax(logits, axis=-1)
        a = p[:, :, 0] - lam * p[:, :, 1]
        return jnp.einsum('bhqk,bhkd->bhqd', a, vf)

    out = lax.map(block, (jnp.arange(nb), q_blocks))
    out = jnp.moveaxis(out, 0, 2).reshape(B, H, S, 2 * d)
    return jnp.transpose(out, (0, 2, 1, 3))


def hybrid_mixer(h, w_in, w_out, sb_norm_g, lam_q1, lam_k1, lam_q2, lam_k2, diff_norm_g,
                 rel_bias, layer_idx):
    B, S, _ = h.shape
    proj = jnp.einsum('bsd,de->bse', h, w_in)
    cuts = list(np.cumsum([SB_WIDTH] * 3 + [DIFF_WIDTH] * 2))
    sb_q, sb_k, sb_v, df_q, df_k, df_v = jnp.split(proj, cuts, axis=-1)

    def sb_heads(t):
        return jnp.transpose(t.reshape(B, S, N_SB_HEADS, HEAD_DIM), (0, 2, 1, 3))
    sb_out = stick_breaking_attention(sb_heads(sb_q), sb_heads(sb_k), sb_heads(sb_v))
    sb_out = rmsnorm(sb_out, sb_norm_g).reshape(B, S, SB_WIDTH)

    def qk_heads(t):
        return jnp.transpose(t.reshape(B, S, N_DIFF_HEADS, 2, HEAD_DIM), (0, 2, 3, 1, 4))
    v_d = jnp.transpose(df_v.reshape(B, S, N_DIFF_HEADS, 2 * HEAD_DIM), (0, 2, 1, 3))
    lam_init = 0.8 - 0.6 * math.exp(-0.3 * layer_idx)
    lam = (jnp.exp(jnp.sum(lam_q1.astype(jnp.float32) * lam_k1.astype(jnp.float32)))
           - jnp.exp(jnp.sum(lam_q2.astype(jnp.float32) * lam_k2.astype(jnp.float32)))
           + lam_init)
    df_out = differential_attention(qk_heads(df_q), qk_heads(df_k), v_d, lam, rel_bias)
    df_out = (rmsnorm(df_out, diff_norm_g) * (1.0 - lam_init)).reshape(B, S, DIFF_WIDTH)

    merged = jnp.concatenate([sb_out, df_out], axis=-1).astype(h.dtype)
    return jnp.einsum('bse,ed->bsd', merged, w_out)


def squared_relu_mlp(h, w_up, w_down):
    u = jnp.einsum('bsd,df->bsf', h, w_up)
    return jnp.einsum('bsf,fd->bsd', jnp.square(jax.nn.relu(u)), w_down)


def setup_inputs(seed: int = 0) -> dict:
    key = jax.random.key(seed)
    ks = jax.random.split(key, 20)
    f32 = jnp.float32

    def nrm(k, shape, scale):
        return jax.random.normal(k, shape, f32) * scale

    x = jax.random.normal(ks[0], (BATCH, SEQ, D_MODEL), f32)
    ln0_g = 1.0 + nrm(ks[1], (D_MODEL,), 0.02)
    ln0_b = nrm(ks[2], (D_MODEL,), 0.02)
    col_scale = np.concatenate([
        np.ones(2 * SB_WIDTH), np.full(SB_WIDTH, INIT_BETA),
        np.ones(2 * DIFF_WIDTH), np.full(DIFF_WIDTH, INIT_BETA)]).astype(np.float32)
    w_in = nrm(ks[3], (DEPTH, D_MODEL, IN_WIDTH), D_MODEL ** -0.5) * jnp.asarray(col_scale)
    w_out = nrm(ks[4], (DEPTH, MIX_WIDTH, D_MODEL), MIX_WIDTH ** -0.5 * INIT_BETA)
    sb_norm_g = 1.0 + nrm(ks[5], (DEPTH, HEAD_DIM), 0.02)
    lam_q1 = nrm(ks[6], (DEPTH, HEAD_DIM), 0.1)
    lam_k1 = nrm(ks[7], (DEPTH, HEAD_DIM), 0.1)
    lam_q2 = nrm(ks[8], (DEPTH, HEAD_DIM), 0.1)
    lam_k2 = nrm(ks[9], (DEPTH, HEAD_DIM), 0.1)
    diff_norm_g = 1.0 + nrm(ks[10], (DEPTH, 2 * HEAD_DIM), 0.02)
    rel_bias = nrm(ks[11], (N_BUCKETS, N_DIFF_HEADS), 0.5)
    ln1_g = 1.0 + nrm(ks[12], (DEPTH, D_MODEL), 0.02)
    ln1_b = nrm(ks[13], (DEPTH, D_MODEL), 0.02)
    w_up = nrm(ks[14], (DEPTH, D_MODEL, D_FF), D_MODEL ** -0.5 * INIT_BETA)
    w_down = nrm(ks[15], (DEPTH, D_FF, D_MODEL), D_FF ** -0.5 * INIT_BETA)
    ln2_g = 1.0 + nrm(ks[16], (DEPTH, D_MODEL), 0.02)
    ln2_b = nrm(ks[17], (DEPTH, D_MODEL), 0.02)
    return {"x": x, "ln0_g": ln0_g, "ln0_b": ln0_b, "w_in": w_in, "w_out": w_out,
            "sb_norm_g": sb_norm_g, "lam_q1": lam_q1, "lam_k1": lam_k1,
            "lam_q2": lam_q2, "lam_k2": lam_k2, "diff_norm_g": diff_norm_g,
            "rel_bias": rel_bias, "ln1_g": ln1_g, "ln1_b": ln1_b,
            "w_up": w_up, "w_down": w_down, "ln2_g": ln2_g, "ln2_b": ln2_b}


def reference(x, ln0_g, ln0_b, w_in, w_out, sb_norm_g, lam_q1, lam_k1, lam_q2, lam_k2,
              diff_norm_g, rel_bias, ln1_g, ln1_b, w_up, w_down, ln2_g, ln2_b):
    h = layernorm(x, ln0_g, ln0_b)
    for l in range(DEPTH):
        mix = hybrid_mixer(h, w_in[l], w_out[l], sb_norm_g[l], lam_q1[l], lam_k1[l],
                           lam_q2[l], lam_k2[l], diff_norm_g[l], rel_bias, l)
        h = layernorm(ALPHA * h + mix, ln1_g[l], ln1_b[l])
        ff = squared_relu_mlp(h, w_up[l], w_down[l])
        h = layernorm(ALPHA * h + ff, ln2_g[l], ln2_b[l])
    return h
```

```cpp
#include <hip/hip_runtime.h>
#include <hip/hip_cooperative_groups.h>
#include <cstdio>
#include <cstdint>
#include <cmath>
namespace cg = cooperative_groups;
namespace pg8 {
#define PG8_LAS __attribute__((address_space(3)))
typedef unsigned short bf16_t;
typedef short bf16x8 __attribute__((ext_vector_type(8)));
typedef float f32x4 __attribute__((ext_vector_type(4)));
typedef unsigned u32x4 __attribute__((ext_vector_type(4)));
constexpr int BM = 256, BK = 64, HALF = 128, HTB = HALF * BK * 2  , STAGE_BYTES = 8 * HTB, NXCD = 8, WGM = 8;

__host__ __device__ __forceinline__ int lds_byte(int r, int c) { const int st = (r >> 4) * 2 + (c >> 5), rr = r & 15, cc = c & 31, ob = rr * 64 + cc * 2; return st * 1024 + (ob ^ (((ob >> 9) & 1) << 5)); }
__host__ __device__ __forceinline__ void stage_rc(int b, int& R, int& C) { const int st = b / 1024, sb = b % 1024, swz = sb ^ (((sb >> 9) & 1) << 5); R = (st >> 1) * 16 + swz / 64; C = (st & 1) * 32 + (swz % 64) / 2; }
__host__ __device__ __forceinline__ int perm32(int rho) { const int n = rho >> 4, i = rho & 15; return 8 * (i >> 2) + 4 * n + (i & 3); }

struct Unit { int pm, pn; };
struct Gemm { const bf16_t* A; const bf16_t* Bt; int M, N, K; };

struct StaticOrder {
    int nM, nN, nwg, G, c;
    __host__ __device__ void init(int M, int N, int G_, int c_) { nM = M / BM; nN = N / BM; nwg = nM * nN; G = G_; c = c_; }
    __host__ __device__ bool next(int i, Unit& u) const {
        const long L = (long)i * G + c; if (L >= nwg) return false;
        int wgid = (int)L; { const int q = nwg / NXCD, r = nwg % NXCD, xcd = wgid % NXCD, off = wgid / NXCD; wgid = (xcd < r ? xcd * (q + 1) : r * (q + 1) + (xcd - r) * q) + off; }
        const int nig = WGM * nN, gid = wgid / nig, fm = gid * WGM, gsz = (nM - fm) < WGM ? (nM - fm) : WGM;
        u.pm = fm + ((wgid % nig) % gsz); u.pn = (wgid % nig) / gsz; return true;
    }
    __device__ __forceinline__ void a_ready(const Unit&) const {}
    __device__ __forceinline__ void done(const Unit&) const {}
};


__device__ __forceinline__ unsigned cvt_pk_bf16(float lo, float hi) {
    typedef float f32x2_t __attribute__((ext_vector_type(2)));
    typedef __bf16 bf16x2_t __attribute__((ext_vector_type(2)));
    f32x2_t v = {lo, hi}; bf16x2_t b = __builtin_convertvector(v, bf16x2_t); return __builtin_bit_cast(unsigned, b);
}
template <int ACT  > struct EpiBf16S {
    static constexpr bool PERM = true, AFTER_DRAIN = false;
    bf16_t* O; int ldc;
    __device__ __forceinline__ void operator()(const f32x4 (&acc)[2][2][4][2], const Unit& u, int wr, int wc, int fr, int fq) const {
        const int row0 = u.pm * BM + wr * 64 + fr; const int col0 = u.pn * BM + wc * 32 + 8 * fq;
#pragma unroll
        for (int ai = 0; ai < 2; ++ai)
#pragma unroll
            for (int m = 0; m < 4; ++m) { bf16_t* rowp = O + (size_t)(row0 + ai * HALF + m * 16) * ldc + col0;
#pragma unroll
                for (int bj = 0; bj < 2; ++bj) { f32x4 v0 = acc[ai][bj][m][0], v1 = acc[ai][bj][m][1];
                    if (ACT == 2) {
#pragma unroll
                        for (int j = 0; j < 4; ++j) { float a = fmaxf(v0[j], 0.f), b = fmaxf(v1[j], 0.f); v0[j] = a * a; v1[j] = b * b; } }
                    u32x4 w; w.x = cvt_pk_bf16(v0[0], v0[1]); w.y = cvt_pk_bf16(v0[2], v0[3]); w.z = cvt_pk_bf16(v1[0], v1[1]); w.w = cvt_pk_bf16(v1[2], v1[3]);
                    *(u32x4*)(rowp + bj * HALF) = w; } }
    }
};
struct EpiResid {
    static constexpr bool PERM = true, AFTER_DRAIN = false;
    float* Y; int ldc; float alpha;
    __device__ __forceinline__ void operator()(const f32x4 (&acc)[2][2][4][2], const Unit& u, int wr, int wc, int fr, int fq) const {
        const int row0 = u.pm * BM + wr * 64 + fr; const int col0 = u.pn * BM + wc * 32 + 8 * fq;
#pragma unroll
        for (int ai = 0; ai < 2; ++ai)
#pragma unroll
            for (int m = 0; m < 4; ++m) { float* rowp = Y + (size_t)(row0 + ai * HALF + m * 16) * ldc + col0;
#pragma unroll
                for (int bj = 0; bj < 2; ++bj) { f32x4 a = *(const f32x4*)(rowp + bj * HALF), b = *(const f32x4*)(rowp + bj * HALF + 4);
                    a = a * alpha + acc[ai][bj][m][0]; b = b * alpha + acc[ai][bj][m][1];
                    *(f32x4*)(rowp + bj * HALF) = a; *(f32x4*)(rowp + bj * HALF + 4) = b; } }
    }
};

__device__ __forceinline__ void row_stats(const float* st, int row, float& mean, float& rstd) {
    typedef float f32x2v __attribute__((ext_vector_type(2)));
    const f32x2v s = *(const f32x2v*)(st + 2 * row); mean = s.x * (1.0f / 2048.0f); rstd = 1.0f / sqrtf(s.y * (1.0f / 2048.0f) - mean * mean + 1e-5f);
}
template <int ACT  , int LDC> struct EpiBf16Ln {
    static constexpr bool PERM = true, AFTER_DRAIN = false;
    bf16_t* O; const float* st; const float* cs; const float* bw;
    __device__ __forceinline__ void operator()(const f32x4 (&acc)[2][2][4][2], const Unit& u, int wr, int wc, int fr, int fq) const {
        const int row0 = u.pm * BM + wr * 64 + fr; const int col0 = u.pn * BM + wc * 32 + 8 * fq;
        f32x4 c[2][2], w[2][2];
#pragma unroll
        for (int bj = 0; bj < 2; ++bj)
#pragma unroll
            for (int n = 0; n < 2; ++n) { c[bj][n] = *(const f32x4*)(cs + col0 + bj * HALF + 4 * n); w[bj][n] = *(const f32x4*)(bw + col0 + bj * HALF + 4 * n); }
        float mu[8], rs[8];
#pragma unroll
        for (int r = 0; r < 8; ++r) row_stats(st, row0 + (r >> 2) * HALF + (r & 3) * 16, mu[r], rs[r]);
#pragma unroll
        for (int ai = 0; ai < 2; ++ai)
#pragma unroll
            for (int m = 0; m < 4; ++m) { const int row = row0 + ai * HALF + m * 16; const float mean = mu[ai * 4 + m], rstd = rs[ai * 4 + m];
                bf16_t* rowp = O + (size_t)row * LDC + col0;
#pragma unroll
                for (int bj = 0; bj < 2; ++bj) { f32x4 v0 = (acc[ai][bj][m][0] - c[bj][0] * mean) * rstd + w[bj][0], v1 = (acc[ai][bj][m][1] - c[bj][1] * mean) * rstd + w[bj][1];
                    if (ACT == 2) {
#pragma unroll
                        for (int j = 0; j < 4; ++j) { float a = fmaxf(v0[j], 0.f), b = fmaxf(v1[j], 0.f); v0[j] = a * a; v1[j] = b * b; } }
                    u32x4 pw; pw.x = cvt_pk_bf16(v0[0], v0[1]); pw.y = cvt_pk_bf16(v0[2], v0[3]); pw.z = cvt_pk_bf16(v1[0], v1[1]); pw.w = cvt_pk_bf16(v1[2], v1[3]);
                    *(u32x4*)(rowp + bj * HALF) = pw; } }
    }
};
template <bool OUTB> struct EpiResidLn2 {
    static constexpr bool PERM = true, AFTER_DRAIN = false;
    const float* Src; float* Dst; bf16_t* YB; const float* st_in; const float* gam; const float* bet; float* st_out;
    static constexpr int ldc = 2048; static constexpr float alpha = 1.4142135623730951f;
    __device__ __forceinline__ void operator()(const f32x4 (&acc)[2][2][4][2], const Unit& u, int wr, int wc, int fr, int fq) const {
        typedef float f32x2v __attribute__((ext_vector_type(2)));
        const int row0 = u.pm * BM + wr * 64 + fr; const int col0 = u.pn * BM + wc * 32 + 8 * fq;
        f32x4 g[2][2], b[2][2];
#pragma unroll
        for (int bj = 0; bj < 2; ++bj)
#pragma unroll
            for (int n = 0; n < 2; ++n) { g[bj][n] = *(const f32x4*)(gam + col0 + bj * HALF + 4 * n); b[bj][n] = *(const f32x4*)(bet + col0 + bj * HALF + 4 * n) * alpha; }
        f32x4 nx[2][2]; f32x2v nst;
        { const int row = row0; nst = *(const f32x2v*)(st_in + 2 * row);
#pragma unroll
          for (int bj = 0; bj < 2; ++bj) { const size_t off = (size_t)row * ldc + col0 + bj * HALF; nx[bj][0] = *(const f32x4*)(Src + off); nx[bj][1] = *(const f32x4*)(Src + off + 4); } }
#pragma unroll
        for (int r = 0; r < 8; ++r) { const int ai = r >> 2, m = r & 3; const int row = row0 + ai * HALF + m * 16;
            f32x4 cx[2][2]; const f32x2v cst = nst;
#pragma unroll
            for (int bj = 0; bj < 2; ++bj) { cx[bj][0] = nx[bj][0]; cx[bj][1] = nx[bj][1]; }
            if (r + 1 < 8) { const int rown = row0 + ((r + 1) >> 2) * HALF + ((r + 1) & 3) * 16; nst = *(const f32x2v*)(st_in + 2 * rown);
#pragma unroll
                for (int bj = 0; bj < 2; ++bj) { const size_t off = (size_t)rown * ldc + col0 + bj * HALF; nx[bj][0] = *(const f32x4*)(Src + off); nx[bj][1] = *(const f32x4*)(Src + off + 4); } }
            const float mean = cst.x * (1.0f / 2048.0f); const float rstd = 1.0f / sqrtf(cst.y * (1.0f / 2048.0f) - mean * mean + 1e-5f);
            const float sc = rstd * alpha; float s1 = 0.f, s2 = 0.f;
#pragma unroll
            for (int bj = 0; bj < 2; ++bj) { const size_t off = (size_t)row * ldc + col0 + bj * HALF;
                const f32x4 a = (cx[bj][0] - mean) * sc * g[bj][0] + b[bj][0] + acc[ai][bj][m][0], d = (cx[bj][1] - mean) * sc * g[bj][1] + b[bj][1] + acc[ai][bj][m][1];
                *(f32x4*)(Dst + off) = a; *(f32x4*)(Dst + off + 4) = d;
                if (OUTB) { u32x4 pw; pw.x = cvt_pk_bf16(a[0], a[1]); pw.y = cvt_pk_bf16(a[2], a[3]); pw.z = cvt_pk_bf16(d[0], d[1]); pw.w = cvt_pk_bf16(d[2], d[3]);
                    *(u32x4*)(YB + off) = pw;
                    s1 += ((a[0] + a[1]) + (a[2] + a[3])) + ((d[0] + d[1]) + (d[2] + d[3]));
                    s2 += ((a[0] * a[0] + a[1] * a[1]) + (a[2] * a[2] + a[3] * a[3])) + ((d[0] * d[0] + d[1] * d[1]) + (d[2] * d[2] + d[3] * d[3])); } }
            if (OUTB) { s1 += __shfl_xor(s1, 16); s2 += __shfl_xor(s2, 16); s1 += __shfl_xor(s1, 32); s2 += __shfl_xor(s2, 32);
                if (fq == 0) { __hip_atomic_fetch_add(st_out + 2 * row, s1, __ATOMIC_RELAXED, __HIP_MEMORY_SCOPE_AGENT); __hip_atomic_fetch_add(st_out + 2 * row + 1, s2, __ATOMIC_RELAXED, __HIP_MEMORY_SCOPE_AGENT); } } }
    }
};

template <class Epi, class Sched, bool ALIGN_EPI = false, bool SP2 = false>
__device__ __forceinline__ void gemm_phase(PG8_LAS unsigned char* lds, const Gemm g, const Sched& S, const Epi& E) {
    const int tid = threadIdx.x, wid = __builtin_amdgcn_readfirstlane(tid >> 6), lane = tid & 63, wr = wid >> 2, wc = wid & 3, fr = lane & 15, fq = lane >> 4;
    const int K = g.K, nt = K / BK;
    unsigned voffA[2], voffB[2];
#pragma unroll
    for (int i = 0; i < 2; ++i) { int R, C; stage_rc(tid * 16 + i * 8192, R, C); const int Rb = Epi::PERM ? ((R & ~31) + perm32(R & 31)) : R;
        voffA[i] = (unsigned)(R * K + C) * 2u; voffB[i] = (unsigned)(Rb * K + C) * 2u; }
    const size_t kstep = (size_t)(BK * 2);
    const size_t hstep = (size_t)HALF * K * 2;
    const size_t tstep = 2 * hstep;
    const unsigned ldsw = (unsigned)wid * 1024u;
    const int aoff = lds_byte(wr * 64 + fr, fq * 8), boff = lds_byte(wc * 32 + fr, fq * 8);
#define PG8_SA(b, h) (((b) * 2 + (h)) * HTB)
#define PG8_SB(b, h) ((4 + (b) * 2 + (h)) * HTB)
#define PG8_STAGE(bufoff, gbase, voff) do { _Pragma("unroll") for (int _i = 0; _i < 2; ++_i) \
        __builtin_amdgcn_global_load_lds((const unsigned*)((const char*)(gbase) + (voff)[_i]), (PG8_LAS unsigned*)(lds + (bufoff) + ldsw + _i * 8192), 16, 0, 0); } while (0)
#define PG8_LDA(dst, b, h) do { _Pragma("unroll") for (int m = 0; m < 4; ++m) _Pragma("unroll") for (int k = 0; k < 2; ++k) dst[m][k] = *(const PG8_LAS bf16x8*)(lds + PG8_SA(b, h) + aoff + m * 2048 + k * 1024); } while (0)
#define PG8_LDB(dst, b, h) do { _Pragma("unroll") for (int n = 0; n < 2; ++n) _Pragma("unroll") for (int k = 0; k < 2; ++k) dst[n][k] = *(const PG8_LAS bf16x8*)(lds + PG8_SB(b, h) + boff + n * 2048 + k * 1024); } while (0)
#define PG8_MMA(ai, bj, At, Bt) do { __builtin_amdgcn_s_setprio(1); _Pragma("unroll") for (int m = 0; m < 4; ++m) _Pragma("unroll") for (int n = 0; n < 2; ++n) _Pragma("unroll") for (int k = 0; k < 2; ++k) \
        acc[ai][bj][m][n] = __builtin_amdgcn_mfma_f32_16x16x32_bf16(Bt[n][k], At[m][k], acc[ai][bj][m][n], 0, 0, 0); __builtin_amdgcn_s_setprio(0); } while (0)
#define PG8_WAIT_V(n) asm volatile("s_waitcnt vmcnt(" #n ")" ::: "memory")
#define PG8_WAIT_L(n) asm volatile("s_waitcnt lgkmcnt(" #n ")" ::: "memory")
#define PG8_BAR __builtin_amdgcn_s_barrier()
#define PG8_SCHED __builtin_amdgcn_sched_barrier(0)
    Unit cur, nxt; int ui = 0;
    if (!S.next(0, cur)) return;
    f32x4 acc[2][2][4][2];
#pragma unroll
    for (int a = 0; a < 2; ++a)
#pragma unroll
        for (int b = 0; b < 2; ++b)
#pragma unroll
            for (int m = 0; m < 4; ++m)
#pragma unroll
                for (int n = 0; n < 2; ++n) acc[a][b][m][n] = (f32x4){0.f, 0.f, 0.f, 0.f};
    bf16x8 At[4][2], B0[2][2], B1[2][2];
    const char* cA = (const char*)g.A + (size_t)cur.pm * tstep; const char* cB = (const char*)g.Bt + (size_t)cur.pn * tstep;
    S.a_ready(cur);
    if constexpr (SP2) {
        PG8_STAGE(PG8_SB(0, 0), cB, voffB); PG8_STAGE(PG8_SB(0, 1), cB + hstep, voffB); PG8_STAGE(PG8_SA(0, 0), cA, voffA); PG8_STAGE(PG8_SA(0, 1), cA + hstep, voffA);
        if (wr == 1) PG8_BAR;
        PG8_WAIT_V(2); PG8_BAR;
        PG8_STAGE(PG8_SB(1, 0), cB + kstep, voffB); PG8_STAGE(PG8_SA(1, 0), cA + kstep, voffA); PG8_STAGE(PG8_SB(1, 1), cB + hstep + kstep, voffB);
        PG8_WAIT_V(6); PG8_BAR;
    } else {
        PG8_STAGE(PG8_SB(0, 0), cB, voffB); PG8_STAGE(PG8_SA(0, 0), cA, voffA); PG8_STAGE(PG8_SB(0, 1), cB + hstep, voffB); PG8_STAGE(PG8_SA(0, 1), cA + hstep, voffA);
        if (wr == 1) PG8_BAR;
        PG8_WAIT_V(4); PG8_BAR;
        PG8_STAGE(PG8_SB(1, 0), cB + kstep, voffB); PG8_STAGE(PG8_SA(1, 0), cA + kstep, voffA); PG8_STAGE(PG8_SB(1, 1), cB + hstep + kstep, voffB);
        PG8_WAIT_V(6); PG8_BAR;
    }
    for (;;) {
        const bool has_next = S.next(ui + 1, nxt);
        const char* nA = has_next ? (const char*)g.A + (size_t)nxt.pm * tstep : cA; const char* nB = has_next ? (const char*)g.Bt + (size_t)nxt.pn * tstep : cB;
        for (int t = 0; t < nt; t += 2) {
            const bool last = (t == nt - 2);
            const char* a1 = cA + (size_t)(t + 1) * kstep;
            const char* a2 = last ? nA : cA + (size_t)(t + 2) * kstep; const char* b2 = last ? nB : cB + (size_t)(t + 2) * kstep;
            const char* a3 = a2 + kstep; const char* b3 = b2 + kstep;
            if (last && has_next) S.a_ready(nxt);
            if constexpr (SP2) {
            PG8_LDB(B0, 0, 0); PG8_LDB(B1, 0, 1); PG8_SCHED; PG8_LDA(At, 0, 0); PG8_STAGE(PG8_SA(1, 1), a1 + hstep, voffA);
            PG8_WAIT_V(8); PG8_WAIT_L(0); PG8_BAR; PG8_MMA(0, 0, At, B0); PG8_MMA(0, 1, At, B1); PG8_BAR; PG8_SCHED;
            PG8_LDA(At, 0, 1); PG8_STAGE(PG8_SB(0, 0), b2, voffB); PG8_STAGE(PG8_SB(0, 1), b2 + hstep, voffB); PG8_STAGE(PG8_SA(0, 0), a2, voffA);
            PG8_WAIT_V(8); PG8_WAIT_L(0); PG8_BAR; PG8_MMA(1, 0, At, B0); PG8_MMA(1, 1, At, B1); PG8_BAR; PG8_SCHED;
            PG8_LDB(B0, 1, 0); PG8_LDB(B1, 1, 1); PG8_SCHED; PG8_LDA(At, 1, 0); PG8_STAGE(PG8_SA(0, 1), a2 + hstep, voffA);
            PG8_WAIT_V(8); PG8_WAIT_L(0); PG8_BAR; PG8_MMA(0, 0, At, B0); PG8_MMA(0, 1, At, B1); PG8_BAR; PG8_SCHED;
            PG8_LDA(At, 1, 1); PG8_STAGE(PG8_SB(1, 0), b3, voffB); PG8_STAGE(PG8_SB(1, 1), b3 + hstep, voffB); PG8_STAGE(PG8_SA(1, 0), a3, voffA);
            PG8_WAIT_V(8); PG8_WAIT_L(0); PG8_BAR; PG8_MMA(1, 0, At, B0); PG8_MMA(1, 1, At, B1); PG8_BAR; PG8_SCHED;
            } else {
            PG8_LDB(B0, 0, 0); PG8_SCHED; PG8_LDA(At, 0, 0); PG8_STAGE(PG8_SA(1, 1), a1 + hstep, voffA);
            PG8_WAIT_L(8); PG8_BAR; PG8_WAIT_L(0); PG8_MMA(0, 0, At, B0); PG8_BAR; PG8_SCHED;
            PG8_LDB(B1, 0, 1); PG8_STAGE(PG8_SB(0, 0), b2, voffB);
            PG8_BAR; PG8_WAIT_L(0); PG8_MMA(0, 1, At, B1); PG8_BAR;
            PG8_LDA(At, 0, 1); PG8_STAGE(PG8_SA(0, 0), a2, voffA);
            PG8_BAR; PG8_WAIT_L(0); PG8_MMA(1, 0, At, B0); PG8_BAR; PG8_SCHED;
            PG8_STAGE(PG8_SB(0, 1), b2 + hstep, voffB);
            PG8_WAIT_V(6); PG8_BAR; PG8_MMA(1, 1, At, B1); PG8_BAR;
            PG8_LDB(B0, 1, 0); PG8_SCHED; PG8_LDA(At, 1, 0); PG8_STAGE(PG8_SA(0, 1), a2 + hstep, voffA);
            PG8_WAIT_L(8); PG8_BAR; PG8_WAIT_L(0); PG8_MMA(0, 0, At, B0); PG8_BAR; PG8_SCHED;
            PG8_LDB(B1, 1, 1); PG8_STAGE(PG8_SB(1, 0), b3, voffB);
            PG8_BAR; PG8_WAIT_L(0); PG8_MMA(0, 1, At, B1); PG8_BAR;
            PG8_LDA(At, 1, 1); PG8_STAGE(PG8_SA(1, 0), a3, voffA);
            PG8_BAR; PG8_WAIT_L(0); PG8_MMA(1, 0, At, B0); PG8_BAR; PG8_SCHED;
            PG8_STAGE(PG8_SB(1, 1), b3 + hstep, voffB);
            PG8_WAIT_V(6); PG8_BAR; PG8_MMA(1, 1, At, B1); PG8_BAR;
            }
        }
        if constexpr (ALIGN_EPI) { if (wr == 0) PG8_BAR; }
        if constexpr (!Epi::AFTER_DRAIN) { E(acc, cur, wr, wc, fr, fq); S.done(cur); }
        if (!has_next) break;
#pragma unroll
        for (int a = 0; a < 2; ++a)
#pragma unroll
            for (int b = 0; b < 2; ++b)
#pragma unroll
                for (int m = 0; m < 4; ++m)
#pragma unroll
                    for (int n = 0; n < 2; ++n) acc[a][b][m][n] = (f32x4){0.f, 0.f, 0.f, 0.f};
        cur = nxt; cA = nA; cB = nB; ++ui;
        if constexpr (ALIGN_EPI) { if (wr == 1) PG8_BAR; }
    }
    PG8_WAIT_V(0);
    if constexpr (!ALIGN_EPI) { if (wr == 0) PG8_BAR; }
    PG8_BAR;
    if constexpr (Epi::AFTER_DRAIN) { E.fused(acc, cur, wr, wc, fr, fq, lds, wid, lane); S.done(cur); }
#undef PG8_SA
#undef PG8_SB
#undef PG8_STAGE
#undef PG8_LDA
#undef PG8_LDB
#undef PG8_MMA
#undef PG8_WAIT_V
#undef PG8_WAIT_L
#undef PG8_BAR
#undef PG8_SCHED
}
}

#define LAS __attribute__((address_space(3)))
typedef unsigned short bf16_t;
typedef short bf16x8 __attribute__((ext_vector_type(8)));
typedef short s16x4 __attribute__((ext_vector_type(4)));
typedef float f32x4 __attribute__((ext_vector_type(4)));
typedef float f32x16 __attribute__((ext_vector_type(16)));
typedef unsigned u32x4 __attribute__((ext_vector_type(4)));
typedef unsigned u32x2 __attribute__((ext_vector_type(2)));

constexpr int DM = 2048, NB = 4, SEQ = 4096, MTOK = NB * SEQ, DEPTH = 2, HD = 128;
constexpr int INW = 6144, DFF = 8192;
constexpr float LN_EPS = 1e-5f, RMS_EPS = 1e-5f;
constexpr float ALPHA = 1.4142135623730951f;
constexpr float LOG2E = 1.4426950408889634f, LN2 = 0.6931471805599453f;
constexpr float QK_SCALE = 0.08838834764831845f;

constexpr size_t MiB = 1u << 20;
constexpr size_t WS_WIN = 2 * MiB, WS_WOUT = WS_WIN + 24 * MiB, WS_WUP = WS_WOUT + 8 * MiB, WS_WDN = WS_WUP + 32 * MiB;
constexpr size_t WS_HB = WS_WDN + 32 * MiB;
constexpr size_t WS_BIG = WS_HB + 64 * MiB;
constexpr size_t WS_QKV = WS_BIG, WS_MRG = WS_BIG + 192 * MiB, WS_U = WS_BIG;
constexpr size_t WS_END = WS_BIG + 256 * MiB;

constexpr int LDS_BYTES = 147456;
constexpr int LDS_TAB = 131072, LDS_FLAGS = 131072 + 1024;

__device__ __forceinline__ float wave_sum(float v) {
#pragma unroll
    for (int o = 32; o >= 1; o >>= 1) v += __shfl_xor(v, o);
    return v;
}
__device__ __forceinline__ unsigned pk2(float lo, float hi) { return pg8::cvt_pk_bf16(lo, hi); }

template <bool WF32, bool WB16>
__device__ __forceinline__ void ln_phase(const float* src, float* dstf, bf16_t* dstb, float* rs, const float* g, const float* bt) {
    const int lane = threadIdx.x & 63, wave = threadIdx.x >> 6; const int step = gridDim.x * 8;
    int row = blockIdx.x * 8 + wave; if (row >= MTOK) return;
    f32x4 gg[8], bb[8], nx[8];
#pragma unroll
    for (int i = 0; i < 8; ++i) { const int c = (i * 64 + lane) * 4; gg[i] = *(const f32x4*)(g + c); bb[i] = *(const f32x4*)(bt + c); nx[i] = *(const f32x4*)(src + (size_t)row * DM + c); }
    for (;;) {
        f32x4 v[8]; float s = 0.f; const int rown = row + step;
#pragma unroll
        for (int i = 0; i < 8; ++i) { v[i] = nx[i]; s += (v[i][0] + v[i][1]) + (v[i][2] + v[i][3]); }
        if (rown < MTOK) {
#pragma unroll
            for (int i = 0; i < 8; ++i) nx[i] = *(const f32x4*)(src + (size_t)rown * DM + (i * 64 + lane) * 4); }
        asm volatile("" ::: "memory");
        const float mean = wave_sum(s) * (1.0f / 2048.0f); float q = 0.f;
#pragma unroll
        for (int i = 0; i < 8; ++i) { v[i] = v[i] - mean; q += (v[i][0] * v[i][0] + v[i][1] * v[i][1]) + (v[i][2] * v[i][2] + v[i][3] * v[i][3]); }
        const float q0_ = wave_sum(q); const float rstd = 1.0f / sqrtf(q0_ * (1.0f / 2048.0f) + LN_EPS);
        if (WB16 && lane == 0) { const float sm = mean * 2048.0f; rs[2 * row] = sm; rs[2 * row + 1] = q0_ + mean * sm; }
#pragma unroll
        for (int i = 0; i < 8; ++i) { const int c = (i * 64 + lane) * 4; const f32x4 y = v[i] * rstd * gg[i] + bb[i];
            if (WF32) *(f32x4*)(dstf + (size_t)row * DM + c) = y;
            if (WB16) { u32x2 w; w.x = pk2(y[0], y[1]); w.y = pk2(y[2], y[3]); *(u32x2*)(dstb + (size_t)row * DM + c) = w; } }
        if (rown >= MTOK) break;
        row = rown;
    }
}

template <bool FOLD>
__device__ __forceinline__ void tconv_mat(const float* W, int K, int N, bf16_t* WT, const float* gam, const float* bet, float* cs, float* bw, LAS float* scr) {
    const int tkn = K / 64, tnn = N / 64, nt = tkn * tnn, tid = threadIdx.x;
    const int kk = tid >> 4, n4 = (tid & 15) * 4, n = tid >> 3, k8 = (tid & 7) * 8;
    int it = blockIdx.x; if (it >= nt) return;
    f32x4 v0, v1;
    { const int tk = it / tnn, tn = it % tnn; const float* p = W + (size_t)(tk * 64 + kk) * N + tn * 64 + n4; v0 = *(const f32x4*)p; v1 = *(const f32x4*)(p + (size_t)32 * N); }
    for (;;) {
        const int tk = it / tnn, tn = it % tnn, nx = it + (int)gridDim.x;
        const f32x4 w0 = v0, w1 = v1;
        if (nx < nt) { const int tk2 = nx / tnn, tn2 = nx % tnn; const float* p = W + (size_t)(tk2 * 64 + kk) * N + tn2 * 64 + n4; v0 = *(const f32x4*)p; v1 = *(const f32x4*)(p + (size_t)32 * N); }
        scr[(n4 + 0) * 65 + kk] = w0[0]; scr[(n4 + 1) * 65 + kk] = w0[1]; scr[(n4 + 2) * 65 + kk] = w0[2]; scr[(n4 + 3) * 65 + kk] = w0[3];
        scr[(n4 + 0) * 65 + kk + 32] = w1[0]; scr[(n4 + 1) * 65 + kk + 32] = w1[1]; scr[(n4 + 2) * 65 + kk + 32] = w1[2]; scr[(n4 + 3) * 65 + kk + 32] = w1[3];
        __syncthreads();
        { float x[8]; float bsum = 0.f, csum = 0.f;
          if (FOLD) { const f32x4 g0 = *(const f32x4*)(gam + tk * 64 + k8), g1 = *(const f32x4*)(gam + tk * 64 + k8 + 4), b0 = *(const f32x4*)(bet + tk * 64 + k8), b1 = *(const f32x4*)(bet + tk * 64 + k8 + 4);
#pragma unroll
              for (int j = 0; j < 8; ++j) { const float xv = scr[n * 65 + k8 + j]; bsum += xv * (j < 4 ? b0[j & 3] : b1[j & 3]); x[j] = xv * (j < 4 ? g0[j & 3] : g1[j & 3]); }
          } else {
#pragma unroll
              for (int j = 0; j < 8; ++j) x[j] = scr[n * 65 + k8 + j]; }
          u32x4 w; w.x = pk2(x[0], x[1]); w.y = pk2(x[2], x[3]); w.z = pk2(x[4], x[5]); w.w = pk2(x[6], x[7]);
          *(u32x4*)(WT + (size_t)(tn * 64 + n) * K + tk * 64 + k8) = w;
          if (FOLD) {
#pragma unroll
              for (int c = 0; c < 4; ++c) csum += __uint_as_float(w[c] << 16) + __uint_as_float(w[c] & 0xffff0000u);
              csum += __shfl_xor(csum, 1); bsum += __shfl_xor(bsum, 1); csum += __shfl_xor(csum, 2); bsum += __shfl_xor(bsum, 2); csum += __shfl_xor(csum, 4); bsum += __shfl_xor(bsum, 4);
              if ((tid & 7) == 0) { __hip_atomic_fetch_add(cs + tn * 64 + n, csum, __ATOMIC_RELAXED, __HIP_MEMORY_SCOPE_AGENT); __hip_atomic_fetch_add(bw + tn * 64 + n, bsum, __ATOMIC_RELAXED, __HIP_MEMORY_SCOPE_AGENT); } } }
        __syncthreads();
        if (nx >= nt) break;
        it = nx;
    }
}
__device__ __forceinline__ void tconv_matrix(const float* W, int K, int N, bf16_t* WT, LAS float* scr) { tconv_mat<false>(W, K, N, WT, nullptr, nullptr, nullptr, nullptr, scr); }
__device__ __forceinline__ void tconv_matrix_fold(const float* W, int K, int N, bf16_t* WT, const float* gam, const float* bet, float* cs, float* bw, LAS float* scr) { tconv_mat<true>(W, K, N, WT, gam, bet, cs, bw, scr); }

#define MFMA32(a, b, c) __builtin_amdgcn_mfma_f32_32x32x16_bf16((a), (b), (c), 0, 0, 0)
__device__ __forceinline__ int crow(int i, int hh) { return (i & 3) + 8 * (i >> 2) + 4 * hh; }
typedef short v4i16_t __attribute__((ext_vector_type(4)));
__device__ __forceinline__ s16x4 vtr(LAS const unsigned char* p) { return __builtin_bit_cast(s16x4, __builtin_amdgcn_ds_read_tr16_b64_v4i16((LAS v4i16_t*)p)); }
__device__ __forceinline__ int t5_bucket(int n) {
    if (n < 16) return n;
    int large = 16 + (int)(logf((float)n * (1.0f / 16.0f)) / 2.0794415416798357f * 16.0f);
    return large < 31 ? large : 31;
}

__device__ __forceinline__ void glds16(const void* gsrc, unsigned lds_dst) { unsigned keep;
    asm volatile("s_mov_b32 %0, m0\n\ts_mov_b32 m0, %2\n\ts_nop 0\n\tglobal_load_lds_dwordx4 %1, off\n\ts_mov_b32 m0, %0" : "=&s"(keep) : "v"(gsrc), "s"(lds_dst) : "memory"); }
template <bool SB>
__device__ __forceinline__ void attn_unit(LAS unsigned char* lds, const bf16_t* qkv, bf16_t* merged, int b, int gi, int qb,
                                          const float* gnorm, float lam, float outscale, const float* rel_bias) {
    constexpr int NDV = SB ? 4 : 8;
    int tid_ = threadIdx.x; asm volatile("" : "+v"(tid_));
    const int tid = tid_, lane = tid & 63, w = __builtin_amdgcn_readfirstlane(tid >> 6), g = w >> 2, sub = w & 3;
    const int r = lane & 31, hh = lane >> 5;
    const int qcol = (SB ? 0 : 3072) + gi * 256, kcol = qcol + 1024, vcol = qcol + 2048;
    const int q0 = qb * 128 + sub * 32, t = q0 + r;
    const size_t rowbase = (size_t)b * SEQ;
    LAS float* tab = (LAS float*)(lds + LDS_TAB);
    LAS int* flags = (LAS int*)(lds + LDS_FLAGS);

    bf16x8 qf[8];
    { const bf16_t* qp = qkv + (rowbase + t) * INW + qcol + g * 128 + 8 * hh;
#pragma unroll
      for (int s = 0; s < 8; ++s) qf[s] = *(const bf16x8*)(qp + 16 * s); }
    if (!SB) { if (tid < 129) tab[tid] = rel_bias[t5_bucket(tid) * 4 + gi] * LOG2E; }

    const int srow = w * 2 + hh;
    const int ck = (r & 16) | ((r & 15) ^ (srow & 15));
    const int cv = (((r >> 2) ^ (srow & 3)) << 2) | (r & 3);
    const size_t soffK = (size_t)srow * INW + kcol + ck * 8, soffV = (size_t)srow * INW + vcol + cv * 8;
    const unsigned kbase = (unsigned)(r * 512 + g * 256 + ((hh ^ (r & 15)) << 4));
    const int i16 = lane & 15, tq = i16 >> 2, tp = i16 & 3, tG = (lane >> 4) & 1;
    const unsigned vq = (unsigned)((4 * hh + tq) * 512 + 32 * tG + 8 * tp + (tq << 6)) + 32768u;

    f32x16 O[NDV];
#pragma unroll
    for (int d = 0; d < NDV; ++d)
#pragma unroll
        for (int i = 0; i < 16; ++i) O[d][i] = 0.f;
    float m = -1e30f, l = 0.f, carry = 0.f;
    bool wdone = false;

    const int ktmax = 2 * qb + 1;
    const unsigned ldsb = (unsigned)(size_t)lds;
#define ISSUE_STAGE(KT, ST) do { const bf16_t* gb_ = qkv + (rowbase + (size_t)(KT) * 64) * INW; \
        _Pragma("unroll") for (int i_ = 0; i_ < 4; ++i_) { \
            glds16(gb_ + soffK + (size_t)i_ * 16 * INW, (unsigned)__builtin_amdgcn_readfirstlane((int)(ldsb + (ST) * 65536 + i_ * 8192 + w * 1024))); \
            glds16(gb_ + soffV + (size_t)i_ * 16 * INW, (unsigned)__builtin_amdgcn_readfirstlane((int)(ldsb + (ST) * 65536 + 32768 + i_ * 8192 + w * 1024))); } } while (0)

    int kt = ktmax, st = 0;
    ISSUE_STAGE(kt, 0);
    for (;;) {
        asm volatile("s_waitcnt vmcnt(0)" ::: "memory");
        __syncthreads();
        if (SB && kt != ktmax) { const int f = flags[(st ^ 1) * 8 + (lane & 7)]; if (__all(f != 0)) break; }
        if (kt > 0) ISSUE_STAGE(kt - 1, st ^ 1);
        LAS const unsigned char* stage = lds + st * 65536;
#pragma unroll
        for (int kbi = 0; kbi < 2; ++kbi) {
            const int kb = 1 - kbi;
            const int s0 = 64 * kt + 32 * kb;
            const bool skip = SB ? (s0 >= q0 + 31 || wdone) : (s0 > q0 + 31);
            if (!skip) {
                f32x16 sacc;
#pragma unroll
                for (int i = 0; i < 16; ++i) sacc[i] = 0.f;
#pragma unroll
                for (int s = 0; s < 8; ++s) { const bf16x8 kf = *(LAS const bf16x8*)(stage + ((kbase ^ (unsigned)(s << 5)) + kb * 16384)); sacc = MFMA32(kf, qf[s], sacc); }
                float p[16];
                if (SB) {
                    float z[16], lf[16];
#pragma unroll
                    for (int i = 0; i < 16; ++i) { const float zz = sacc[i] * QK_SCALE; const bool valid = (s0 + crow(i, hh)) < t;
                        const float e = __builtin_amdgcn_exp2f(-fabsf(zz) * LOG2E);
                        const float sp = fmaxf(zz, 0.f) + LN2 * __builtin_amdgcn_logf(1.0f + e);
                        lf[i] = valid ? -sp : 0.f; z[i] = zz; }
                    float gs[4], pg[4];
#pragma unroll
                    for (int q4 = 0; q4 < 4; ++q4) { gs[q4] = (lf[4 * q4] + lf[4 * q4 + 1]) + (lf[4 * q4 + 2] + lf[4 * q4 + 3]); pg[q4] = __shfl_xor(gs[q4], 32); }
                    float run = carry;
#pragma unroll
                    for (int q4 = 3; q4 >= 0; --q4) {
                        const float base = run + (hh == 0 ? pg[q4] : 0.f);
                        const float s3 = base, s2 = s3 + lf[4 * q4 + 3], s1 = s2 + lf[4 * q4 + 2], s0f = s1 + lf[4 * q4 + 1];
                        const float sf[4] = {s0f, s1, s2, s3};
#pragma unroll
                        for (int j = 0; j < 4; ++j) { const int i = 4 * q4 + j; const bool valid = (s0 + crow(i, hh)) < t;
                            const float wv = __builtin_amdgcn_exp2f((z[i] + lf[i] + sf[j]) * LOG2E); p[i] = valid ? wv : 0.f; }
                        run += gs[q4] + pg[q4];
                    }
                    carry = run;
                } else {
                    float tv[16];
                    constexpr float C = QK_SCALE * LOG2E;
                    if (s0 + 31 + 128 <= q0) { const float cb = tab[128];
#pragma unroll
                        for (int i = 0; i < 16; ++i) tv[i] = sacc[i] * C + cb;
                    } else {
#pragma unroll
                        for (int i = 0; i < 16; ++i) { const int dist = t - (s0 + crow(i, hh)); const int idx = dist < 0 ? 0 : (dist > 128 ? 128 : dist);
                            const float bv = tab[idx]; tv[i] = dist >= 0 ? sacc[i] * C + bv : -1e30f; }
                    }
                    float mx = tv[0];
#pragma unroll
                    for (int i = 1; i < 16; ++i) mx = fmaxf(mx, tv[i]);
                    mx = fmaxf(mx, __shfl_xor(mx, 32));
                    if (__any(mx > m + 8.0f)) { const float mn = fmaxf(m, mx); const float corr = __builtin_amdgcn_exp2f(m - mn); m = mn; l *= corr;
#pragma unroll
                        for (int d = 0; d < NDV; ++d)
#pragma unroll
                            for (int i = 0; i < 16; ++i) O[d][i] *= corr; }
                    float ps = 0.f;
#pragma unroll
                    for (int i = 0; i < 16; ++i) { p[i] = __builtin_amdgcn_exp2f(tv[i] - m); ps += p[i]; }
                    l += ps;
                }
                bf16x8 pf[2];
#pragma unroll
                for (int s = 0; s < 2; ++s) { u32x4 pw; pw.x = pk2(p[8 * s + 0], p[8 * s + 1]); pw.y = pk2(p[8 * s + 2], p[8 * s + 3]); pw.z = pk2(p[8 * s + 4], p[8 * s + 5]); pw.w = pk2(p[8 * s + 6], p[8 * s + 7]);
                    pf[s] = __builtin_bit_cast(bf16x8, pw); }
#pragma unroll
                for (int d = 0; d < NDV; ++d) { const int dg = SB ? g * 4 + d : d; const unsigned va = vq ^ (unsigned)(dg << 6);
#pragma unroll
                    for (int s = 0; s < 2; ++s) {
                        const s16x4 lo = vtr(stage + va + (kb * 32 + 16 * s) * 512), hi = vtr(stage + va + (kb * 32 + 16 * s + 8) * 512);
                        const bf16x8 vf = __builtin_shufflevector(lo, hi, 0, 1, 2, 3, 4, 5, 6, 7);
                        O[d] = MFMA32(vf, pf[s], O[d]); } }
            }
        }
        if (SB) { wdone = __all(carry < -100.0f); if (lane == 0) flags[st * 8 + w] = wdone ? 1 : 0; }
        if (kt == 0) break;
        --kt; st ^= 1;
    }
#undef ISSUE_STAGE
    __syncthreads();
    if (SB) {
        float ss = 0.f;
#pragma unroll
        for (int d = 0; d < NDV; ++d)
#pragma unroll
            for (int i = 0; i < 16; ++i) ss += O[d][i] * O[d][i];
        ss += __shfl_xor(ss, 32);
        const float rstd = 1.0f / sqrtf(ss * (1.0f / 128.0f) + RMS_EPS);
        bf16_t* op = merged + (rowbase + t) * DM + gi * 256 + g * 128 + 4 * hh;
#pragma unroll
        for (int d = 0; d < NDV; ++d)
#pragma unroll
            for (int q4 = 0; q4 < 4; ++q4) { const int dv = d * 32 + 8 * q4; const f32x4 gg = *(const f32x4*)(gnorm + dv + 4 * hh);
                u32x2 o; o.x = pk2(O[d][4 * q4] * rstd * gg[0], O[d][4 * q4 + 1] * rstd * gg[1]); o.y = pk2(O[d][4 * q4 + 2] * rstd * gg[2], O[d][4 * q4 + 3] * rstd * gg[3]);
                *(u32x2*)(op + dv) = o; }
    } else {
        const float lt = l + __shfl_xor(l, 32);
        LAS float* ex = (LAS float*)lds + (size_t)sub * (NDV * 16 * 64) + lane;
        if (g == 1) { const float sc = lam / lt;
#pragma unroll
            for (int d = 0; d < NDV; ++d)
#pragma unroll
                for (int i = 0; i < 16; ++i) ex[(d * 16 + i) * 64] = O[d][i] * sc; }
        __syncthreads();
        if (g == 0) { const float sc = 1.0f / lt; float ss = 0.f;
#pragma unroll
            for (int d = 0; d < NDV; ++d)
#pragma unroll
                for (int i = 0; i < 16; ++i) { const float x = O[d][i] * sc - ex[(d * 16 + i) * 64]; O[d][i] = x; ss += x * x; }
            ss += __shfl_xor(ss, 32);
            const float rstd = outscale / sqrtf(ss * (1.0f / 256.0f) + RMS_EPS);
            bf16_t* op = merged + (rowbase + t) * DM + 1024 + gi * 256 + 4 * hh;
#pragma unroll
            for (int d = 0; d < NDV; ++d)
#pragma unroll
                for (int q4 = 0; q4 < 4; ++q4) { const int dv = d * 32 + 8 * q4; const f32x4 gg = *(const f32x4*)(gnorm + dv + 4 * hh);
                    u32x2 o; o.x = pk2(O[d][4 * q4] * rstd * gg[0], O[d][4 * q4 + 1] * rstd * gg[1]); o.y = pk2(O[d][4 * q4 + 2] * rstd * gg[2], O[d][4 * q4 + 3] * rstd * gg[3]);
                    *(u32x2*)(op + dv) = o; } }
    }
    __syncthreads();
}


#define XB_TMO      128
#define XB_XCNT(j)  (256  + 64 * (j))
#define XB_XSUB(j)  (1280 + 64 * (j))
#define XB_XGEN(j)  (2304 + 64 * (j))
#define XB_TOP      3328
#define XB_TOPGEN   3392
#define XCD_BAR_WORDS 3456
#define XB_SPIN_CAP (1u << 18)
__device__ __forceinline__ unsigned xb_ld(unsigned* p)              { return __hip_atomic_load(p, __ATOMIC_RELAXED, __HIP_MEMORY_SCOPE_AGENT); }
__device__ __forceinline__ unsigned xb_add(unsigned* p, unsigned v) { return __hip_atomic_fetch_add(p, v, __ATOMIC_RELAXED, __HIP_MEMORY_SCOPE_AGENT); }
__device__ __forceinline__ unsigned xb_xcc_id() { return (unsigned)__builtin_amdgcn_s_getreg((3 << 11) | 20) & 0xFu; }
#define XB_SPIN(cond, bar) do { unsigned _sp = 0; while (cond) { __builtin_amdgcn_s_sleep(1); \
    if ((++_sp & 255u) == 0u) { if (xb_ld(&(bar)[XB_TMO])) break; if (_sp > XB_SPIN_CAP) { atomicAdd(&(bar)[XB_TMO], 1u); break; } } } } while (0)
__device__ __forceinline__ void xcd_barrier_complete(unsigned* bar, unsigned x, unsigned& nloc, unsigned& nx) {
    const unsigned G = gridDim.x * gridDim.y * gridDim.z;
    unsigned sum, cnt, mine, sp = 0u;
    for (;;) {
        sum = 0u; cnt = 0u; mine = 0u;
#pragma unroll
        for (unsigned j = 0; j < 16; ++j) { const unsigned c = xb_ld(&bar[XB_XCNT(j)]); sum += c; cnt += (c > 0u) ? 1u : 0u; mine = (j == x) ? c : mine; }
        if (sum == G) break;
        __builtin_amdgcn_s_sleep(1);
        if ((++sp & 255u) == 0u) { if (xb_ld(&bar[XB_TMO])) break; if (sp > XB_SPIN_CAP) { atomicAdd(&bar[XB_TMO], 1u); break; } }
    }
    nloc = mine > 0u ? mine : 1u; nx = cnt > 0u ? cnt : 1u;
}
__device__ __forceinline__ void xcd_barrier(unsigned* bar, volatile LAS unsigned* st) {
    asm volatile("s_waitcnt vmcnt(0)" ::: "memory");
    __syncthreads();
    if (threadIdx.x == 0) {
        __builtin_amdgcn_s_waitcnt(0);
        const unsigned x = xb_xcc_id();
        unsigned nloc = st[0], nx = st[1];
        if (nloc == 0u) { xcd_barrier_complete(bar, x, nloc, nx); st[0] = nloc; st[1] = nx; }
        const unsigned old = xb_add(&bar[XB_XSUB(x)], 1u);
        const unsigned gen = old / nloc;
        if (old + 1u == (gen + 1u) * nloc) {
            __builtin_amdgcn_fence(__ATOMIC_RELEASE, "agent");
            asm volatile("s_waitcnt vmcnt(0)" ::: "memory");
            const unsigned og = xb_add(&bar[XB_TOP], 1u);
            const unsigned tg = og / nx;
            if (og + 1u == (tg + 1u) * nx) xb_add(&bar[XB_TOPGEN], 1u);
            else XB_SPIN(xb_ld(&bar[XB_TOPGEN]) == tg, bar);
            __builtin_amdgcn_fence(__ATOMIC_ACQUIRE, "agent");
            xb_add(&bar[XB_XGEN(x)], 1u);
            asm volatile("s_waitcnt vmcnt(0)" ::: "memory");
        } else {
            XB_SPIN(xb_ld(&bar[XB_XGEN(x)]) == gen, bar);
            __builtin_amdgcn_fence(__ATOMIC_ACQUIRE, "agent");
            asm volatile("s_waitcnt vmcnt(0)" ::: "memory");
        }
    }
    __syncthreads();
}

struct Args { const float* in[18]; float* out; unsigned char* ws; int ph_lo, ph_hi; };

typedef const Args __attribute__((address_space(4))) CArgs;
__device__ __forceinline__ CArgs* kargs() { CArgs* p = (CArgs*)__builtin_amdgcn_kernarg_segment_ptr(); asm volatile("" : "+s"(p)); return p; }
#define AIN(i) (kargs()->in[i])
__global__ void __launch_bounds__(512, 2) fwd_mega(Args a) {
    extern __shared__ __attribute__((aligned(16))) unsigned char lds_raw[];
    LAS unsigned char* lds = (LAS unsigned char*)lds_raw;
    cg::grid_group grid = cg::this_grid();
    unsigned char* ws = kargs()->ws;
    float* H = kargs()->out;
    bf16_t* HB = (bf16_t*)(ws + WS_HB);
    bf16_t* QKV = (bf16_t*)(ws + WS_QKV); bf16_t* MRG = (bf16_t*)(ws + WS_MRG); bf16_t* U = (bf16_t*)(ws + WS_U);
    const int lo = kargs()->ph_lo, hi = kargs()->ph_hi; const int G = gridDim.x, c = blockIdx.x;
    const int lane = threadIdx.x & 63;
    unsigned* BAR = (unsigned*)(ws + 1 * MiB);
    volatile LAS unsigned* BST = (volatile LAS unsigned*)(lds + LDS_FLAGS + 512);
    if (threadIdx.x == 0) { BST[0] = 0u; BST[1] = 0u; }
    __syncthreads();
#define IN(k) (lo <= (k) && (k) < hi)
#define SYNC(k) do { if (IN(k) && IN((k) + 1)) xcd_barrier(BAR, BST); } while (0)

#define ST(i) ((float*)ws + (size_t)(i) * MTOK * 2)
#define FOLDV(l, o) ((float*)(ws + 3 * MiB / 2) + (l) * 28672 + (o))
#define CSUP(l) FOLDV(l, 0)
#define BWUP(l) FOLDV(l, 8192)
#define CSIN(l) FOLDV(l, 16384)
#define BWIN(l) FOLDV(l, 22528)
    if (IN(0)) {
        ln_phase<false, true>(AIN(0), H, HB, ST(0), AIN(1), AIN(2));
        tconv_matrix(AIN(3), DM, INW, (bf16_t*)(ws + WS_WIN), (LAS float*)lds);
        tconv_matrix(AIN(4), DM, DM, (bf16_t*)(ws + WS_WOUT), (LAS float*)lds);
        tconv_matrix(AIN(15), DFF, DM, (bf16_t*)(ws + WS_WDN), (LAS float*)lds);
        { float* z1 = ST(1); for (int i = blockIdx.x * 512 + threadIdx.x; i < 3 * MTOK * 2; i += gridDim.x * 512) z1[i] = 0.f;
          float* z2 = FOLDV(0, 0); for (int i = blockIdx.x * 512 + threadIdx.x; i < 2 * 28672; i += gridDim.x * 512) z2[i] = 0.f;
          if (blockIdx.x == 0) for (int i = threadIdx.x; i < XCD_BAR_WORDS; i += 512) __hip_atomic_store(BAR + i, 0u, __ATOMIC_RELAXED, __HIP_MEMORY_SCOPE_AGENT); }
    }
    if (IN(0) && IN(1)) {
        grid.sync();
        if (threadIdx.x == 0) (void)xb_add(&BAR[XB_XCNT(xb_xcc_id())], 1u);
    }
    { constexpr int l = 0; constexpr int pb = 1;
        if (IN(pb + 0)) {
            pg8::Gemm g{HB, (const bf16_t*)(ws + WS_WIN), MTOK, INW, DM}; pg8::StaticOrder S; S.init(MTOK, INW, G, c);
            pg8::EpiBf16S<0> E{QKV, INW};
            pg8::gemm_phase<pg8::EpiBf16S<0>, pg8::StaticOrder, true, true>(lds, g, S, E);
            tconv_matrix_fold(AIN(14), DM, DFF, (bf16_t*)(ws + WS_WUP), AIN(12), AIN(13), CSUP(0), BWUP(0), (LAS float*)lds);
        }
        SYNC(pb + 0);
        if (IN(pb + 1)) {
            const float lam_init = (l == 0) ? 0.2f : 0.35550906759f;
            float d1 = AIN(6)[l * HD + lane] * AIN(7)[l * HD + lane] + AIN(6)[l * HD + 64 + lane] * AIN(7)[l * HD + 64 + lane];
            float d2 = AIN(8)[l * HD + lane] * AIN(9)[l * HD + lane] + AIN(8)[l * HD + 64 + lane] * AIN(9)[l * HD + 64 + lane];
            d1 = wave_sum(d1); d2 = wave_sum(d2);
            const float lam = __builtin_bit_cast(float, __builtin_amdgcn_readfirstlane(__builtin_bit_cast(int, expf(d1) - expf(d2) + lam_init)));
            const int vc = (G % 8 == 0) ? (c % 8) * (G / 8) + c / 8 : c;
            for (int it = vc; it < 256; it += G) {
                const int bh = it >> 4, j = it & 15;
#pragma unroll 1
                for (int k = 0; k < 2; ++k)
                    attn_unit<false>(lds, QKV, MRG, bh >> 2, bh & 3, k == 0 ? 31 - j : j, AIN(10) + l * 256, lam, 1.0f - lam_init, AIN(11));
            }
            for (int it = vc; it < 512; it += G) {
                const int bp = it >> 5, qb = it & 31;
                attn_unit<true>(lds, QKV, MRG, bp >> 2, bp & 3, qb, AIN(5) + l * HD, 0.f, 1.f, nullptr);
            }
        }
        SYNC(pb + 1);
        if (IN(pb + 2)) {
            pg8::Gemm g{MRG, (const bf16_t*)(ws + WS_WOUT), MTOK, DM, DM}; pg8::StaticOrder S; S.init(MTOK, DM, G, c);
            pg8::EpiResidLn2<true> E{AIN(0), H, HB, ST(0), AIN(1), AIN(2), ST(1)};
            pg8::gemm_phase<pg8::EpiResidLn2<true>, pg8::StaticOrder, true, true>(lds, g, S, E);
        }
        SYNC(pb + 2);
        if (IN(pb + 3)) {
            pg8::Gemm g{HB, (const bf16_t*)(ws + WS_WUP), MTOK, DFF, DM}; pg8::StaticOrder S; S.init(MTOK, DFF, G, c);
            pg8::EpiBf16Ln<2, DFF> E{U, ST(1), CSUP(0), BWUP(0)};
            pg8::gemm_phase<pg8::EpiBf16Ln<2, DFF>, pg8::StaticOrder, true, true>(lds, g, S, E);
        }
        SYNC(pb + 3);
        if (IN(pb + 4)) {
            pg8::Gemm g{U, (const bf16_t*)(ws + WS_WDN), MTOK, DM, DFF}; pg8::StaticOrder S; S.init(MTOK, DM, G, c);
            pg8::EpiResidLn2<true> E{H, H, HB, ST(1), AIN(12), AIN(13), ST(2)};
            pg8::gemm_phase<pg8::EpiResidLn2<true>, pg8::StaticOrder, true, true>(lds, g, S, E);
        }
        SYNC(pb + 4);
        if (IN(pb + 5)) {
            tconv_matrix_fold(AIN(3) + (size_t)DM * INW, DM, INW, (bf16_t*)(ws + WS_WIN), AIN(16), AIN(17), CSIN(1), BWIN(1), (LAS float*)lds);
            tconv_matrix(AIN(4) + (size_t)DM * DM, DM, DM, (bf16_t*)(ws + WS_WOUT), (LAS float*)lds);
            tconv_matrix_fold(AIN(14) + (size_t)DM * DFF, DM, DFF, (bf16_t*)(ws + WS_WUP), AIN(12) + DM, AIN(13) + DM, CSUP(1), BWUP(1), (LAS float*)lds);
            tconv_matrix(AIN(15) + (size_t)DFF * DM, DFF, DM, (bf16_t*)(ws + WS_WDN), (LAS float*)lds);
        }
        SYNC(pb + 5);
    }
    { constexpr int l = 1; constexpr int pb = 7;
        if (IN(pb + 0)) {
            pg8::Gemm g{HB, (const bf16_t*)(ws + WS_WIN), MTOK, INW, DM}; pg8::StaticOrder S; S.init(MTOK, INW, G, c);
            pg8::EpiBf16Ln<0, INW> E{QKV, ST(2), CSIN(1), BWIN(1)};
            pg8::gemm_phase<pg8::EpiBf16Ln<0, INW>, pg8::StaticOrder, true, true>(lds, g, S, E);
        }
        SYNC(pb + 0);
        if (IN(pb + 1)) {
            const float lam_init = (l == 0) ? 0.2f : 0.35550906759f;
            float d1 = AIN(6)[l * HD + lane] * AIN(7)[l * HD + lane] + AIN(6)[l * HD + 64 + lane] * AIN(7)[l * HD + 64 + lane];
            float d2 = AIN(8)[l * HD + lane] * AIN(9)[l * HD + lane] + AIN(8)[l * HD + 64 + lane] * AIN(9)[l * HD + 64 + lane];
            d1 = wave_sum(d1); d2 = wave_sum(d2);
            const float lam = __builtin_bit_cast(float, __builtin_amdgcn_readfirstlane(__builtin_bit_cast(int, expf(d1) - expf(d2) + lam_init)));
            const int vc = (G % 8 == 0) ? (c % 8) * (G / 8) + c / 8 : c;
            for (int it = vc; it < 256; it += G) {
                const int bh = it >> 4, j = it & 15;
#pragma unroll 1
                for (int k = 0; k < 2; ++k)
                    attn_unit<false>(lds, QKV, MRG, bh >> 2, bh & 3, k == 0 ? 31 - j : j, AIN(10) + l * 256, lam, 1.0f - lam_init, AIN(11));
            }
            for (int it = vc; it < 512; it += G) {
                const int bp = it >> 5, qb = it & 31;
                attn_unit<true>(lds, QKV, MRG, bp >> 2, bp & 3, qb, AIN(5) + l * HD, 0.f, 1.f, nullptr);
            }
        }
        SYNC(pb + 1);
        if (IN(pb + 2)) {
            pg8::Gemm g{MRG, (const bf16_t*)(ws + WS_WOUT), MTOK, DM, DM}; pg8::StaticOrder S; S.init(MTOK, DM, G, c);
            pg8::EpiResidLn2<true> E{H, H, HB, ST(2), AIN(16), AIN(17), ST(3)};
            pg8::gemm_phase<pg8::EpiResidLn2<true>, pg8::StaticOrder, true, true>(lds, g, S, E);
        }
        SYNC(pb + 2);
        if (IN(pb + 3)) {
            pg8::Gemm g{HB, (const bf16_t*)(ws + WS_WUP), MTOK, DFF, DM}; pg8::StaticOrder S; S.init(MTOK, DFF, G, c);
            pg8::EpiBf16Ln<2, DFF> E{U, ST(3), CSUP(1), BWUP(1)};
            pg8::gemm_phase<pg8::EpiBf16Ln<2, DFF>, pg8::StaticOrder, true, true>(lds, g, S, E);
        }
        SYNC(pb + 3);
        if (IN(pb + 4)) {
            pg8::Gemm g{U, (const bf16_t*)(ws + WS_WDN), MTOK, DM, DFF}; pg8::StaticOrder S; S.init(MTOK, DM, G, c);
            pg8::EpiResidLn2<false> E{H, H, HB, ST(3), AIN(12) + DM, AIN(13) + DM, ST(3)};
            pg8::gemm_phase<pg8::EpiResidLn2<false>, pg8::StaticOrder, true, true>(lds, g, S, E);
        }
        SYNC(pb + 4);
        if (IN(pb + 5)) ln_phase<true, false>(H, H, HB, ST(0), AIN(16) + DM, AIN(17) + DM);
        SYNC(pb + 5);
    }
#undef ST
#undef FOLDV
#undef CSUP
#undef BWUP
#undef CSIN
#undef BWIN
#undef IN
#undef SYNC
}

#ifndef MK_SPLIT
#define MK_SPLIT 0
#endif
extern "C" void kernel_launch(void* const* d_in, const int* in_sizes, int n_in, void* d_out, int out_size, void* d_ws, size_t ws_size, hipStream_t stream) {
    static int grid = 0;
    if (grid == 0) {
        if (n_in != 18 || out_size != MTOK * DM || ws_size < WS_END) { fprintf(stderr, "kernel_launch: unexpected shapes (n_in %d out %d ws %zu)\n", n_in, out_size, ws_size); grid = -1; return; }
        int dev = 0, cus = 0, per_cu = 0;
        hipGetDevice(&dev); hipDeviceGetAttribute(&cus, hipDeviceAttributeMultiprocessorCount, dev);
        if (hipFuncSetAttribute((const void*)fwd_mega, hipFuncAttributeMaxDynamicSharedMemorySize, LDS_BYTES) != hipSuccess) { fprintf(stderr, "kernel_launch: hipFuncSetAttribute failed\n"); grid = -1; return; }
        if (hipOccupancyMaxActiveBlocksPerMultiprocessor(&per_cu, (const void*)fwd_mega, 512, LDS_BYTES) != hipSuccess || per_cu < 1) { fprintf(stderr, "kernel_launch: occupancy query says %d\n", per_cu); per_cu = 1; }
        (void)hipGetLastError();
        grid = cus;
    }
    if (grid < 0) return;
    Args a{};
    for (int i = 0; i < 18; ++i) a.in[i] = (const float*)d_in[i];
    a.out = (float*)d_out; a.ws = (unsigned char*)d_ws;
    constexpr int NPH = 1 + 6 * DEPTH;
#if MK_SPLIT
    for (int p = 0; p < NPH; ++p) { a.ph_lo = p; a.ph_hi = p + 1; void* args[] = {&a};
        hipError_t e = hipLaunchCooperativeKernel((const void*)fwd_mega, dim3(grid), dim3(512), args, LDS_BYTES, stream);
        if (e != hipSuccess) { fprintf(stderr, "kernel_launch: cooperative launch failed: %s\n", hipGetErrorString(e)); break; } }
#else
    a.ph_lo = 0; a.ph_hi = NPH; void* args[] = {&a};
    hipError_t e = hipLaunchCooperativeKernel((const void*)fwd_mega, dim3(grid), dim3(512), args, LDS_BYTES, stream);
    if (e != hipSuccess) fprintf(stderr, "kernel_launch: cooperative launch failed: %s (grid %d)\n", hipGetErrorString(e), grid);
#endif
}
```

```cpp
#include <hip/hip_runtime.h>
#include <hip/hip_cooperative_groups.h>
#include <cstdio>
#include <cstdint>
#include <cmath>
namespace cg = cooperative_groups;
namespace pg8 {
#define PG8_LAS __attribute__((address_space(3)))
typedef unsigned short bf16_t;
typedef short bf16x8 __attribute__((ext_vector_type(8)));
typedef float f32x4 __attribute__((ext_vector_type(4)));
typedef unsigned u32x4 __attribute__((ext_vector_type(4)));
constexpr int BM = 256, BK = 64, HALF = 128, HTB = HALF * BK * 2  , STAGE_BYTES = 8 * HTB, NXCD = 8, WGM = 8;

__host__ __device__ __forceinline__ int lds_byte(int r, int c) { const int st = (r >> 4) * 2 + (c >> 5), rr = r & 15, cc = c & 31, ob = rr * 64 + cc * 2; return st * 1024 + (ob ^ (((ob >> 9) & 1) << 5)); }
__host__ __device__ __forceinline__ void stage_rc(int b, int& R, int& C) { const int st = b / 1024, sb = b % 1024, swz = sb ^ (((sb >> 9) & 1) << 5); R = (st >> 1) * 16 + swz / 64; C = (st & 1) * 32 + (swz % 64) / 2; }
__host__ __device__ __forceinline__ int perm32(int rho) { const int n = rho >> 4, i = rho & 15; return 8 * (i >> 2) + 4 * n + (i & 3); }

struct Unit { int pm, pn; };
struct Gemm { const bf16_t* A; const bf16_t* Bt; int M, N, K; };

struct StaticOrder {
    int nM, nN, nwg, G, c;
    __host__ __device__ void init(int M, int N, int G_, int c_) { nM = M / BM; nN = N / BM; nwg = nM * nN; G = G_; c = c_; }
    __host__ __device__ bool next(int i, Unit& u) const {
        const long L = (long)i * G + c; if (L >= nwg) return false;
        int wgid = (int)L; { const int q = nwg / NXCD, r = nwg % NXCD, xcd = wgid % NXCD, off = wgid / NXCD; wgid = (xcd < r ? xcd * (q + 1) : r * (q + 1) + (xcd - r) * q) + off; }
        const int nig = WGM * nN, gid = wgid / nig, fm = gid * WGM, gsz = (nM - fm) < WGM ? (nM - fm) : WGM;
        u.pm = fm + ((wgid % nig) % gsz); u.pn = (wgid % nig) / gsz; return true;
    }
    __device__ __forceinline__ void a_ready(const Unit&) const {}
    __device__ __forceinline__ void done(const Unit&) const {}
};


__device__ __forceinline__ unsigned cvt_pk_bf16(float lo, float hi) {
    typedef float f32x2_t __attribute__((ext_vector_type(2)));
    typedef __bf16 bf16x2_t __attribute__((ext_vector_type(2)));
    f32x2_t v = {lo, hi}; bf16x2_t b = __builtin_convertvector(v, bf16x2_t); return __builtin_bit_cast(unsigned, b);
}
template <int ACT  > struct EpiBf16S {
    static constexpr bool PERM = true, AFTER_DRAIN = false;
    bf16_t* O; int ldc;
    __device__ __forceinline__ void operator()(const f32x4 (&acc)[2][2][4][2], const Unit& u, int wr, int wc, int fr, int fq) const {
        const int row0 = u.pm * BM + wr * 64 + fr; const int col0 = u.pn * BM + wc * 32 + 8 * fq;
#pragma unroll
        for (int ai = 0; ai < 2; ++ai)
#pragma unroll
            for (int m = 0; m < 4; ++m) { bf16_t* rowp = O + (size_t)(row0 + ai * HALF + m * 16) * ldc + col0;
#pragma unroll
                for (int bj = 0; bj < 2; ++bj) { f32x4 v0 = acc[ai][bj][m][0], v1 = acc[ai][bj][m][1];
                    if (ACT == 2) {
#pragma unroll
                        for (int j = 0; j < 4; ++j) { float a = fmaxf(v0[j], 0.f), b = fmaxf(v1[j], 0.f); v0[j] = a * a; v1[j] = b * b; } }
                    u32x4 w; w.x = cvt_pk_bf16(v0[0], v0[1]); w.y = cvt_pk_bf16(v0[2], v0[3]); w.z = cvt_pk_bf16(v1[0], v1[1]); w.w = cvt_pk_bf16(v1[2], v1[3]);
                    *(u32x4*)(rowp + bj * HALF) = w; } }
    }
};
struct EpiResid {
    static constexpr bool PERM = true, AFTER_DRAIN = false;
    float* Y; int ldc; float alpha;
    __device__ __forceinline__ void operator()(const f32x4 (&acc)[2][2][4][2], const Unit& u, int wr, int wc, int fr, int fq) const {
        const int row0 = u.pm * BM + wr * 64 + fr; const int col0 = u.pn * BM + wc * 32 + 8 * fq;
#pragma unroll
        for (int ai = 0; ai < 2; ++ai)
#pragma unroll
            for (int m = 0; m < 4; ++m) { float* rowp = Y + (size_t)(row0 + ai * HALF + m * 16) * ldc + col0;
#pragma unroll
                for (int bj = 0; bj < 2; ++bj) { f32x4 a = *(const f32x4*)(rowp + bj * HALF), b = *(const f32x4*)(rowp + bj * HALF + 4);
                    a = a * alpha + acc[ai][bj][m][0]; b = b * alpha + acc[ai][bj][m][1];
                    *(f32x4*)(rowp + bj * HALF) = a; *(f32x4*)(rowp + bj * HALF + 4) = b; } }
    }
};

__device__ __forceinline__ void row_stats(const float* st, int row, float& mean, float& rstd) {
    typedef float f32x2v __attribute__((ext_vector_type(2)));
    const f32x2v s = *(const f32x2v*)(st + 2 * row); mean = s.x * (1.0f / 2048.0f); rstd = 1.0f / sqrtf(s.y * (1.0f / 2048.0f) - mean * mean + 1e-5f);
}
template <int ACT  , int LDC> struct EpiBf16Ln {
    static constexpr bool PERM = true, AFTER_DRAIN = false;
    bf16_t* O; const float* st; const float* cs; const float* bw;
    __device__ __forceinline__ void operator()(const f32x4 (&acc)[2][2][4][2], const Unit& u, int wr, int wc, int fr, int fq) const {
        const int row0 = u.pm * BM + wr * 64 + fr; const int col0 = u.pn * BM + wc * 32 + 8 * fq;
        f32x4 c[2][2], w[2][2];
#pragma unroll
        for (int bj = 0; bj < 2; ++bj)
#pragma unroll
            for (int n = 0; n < 2; ++n) { c[bj][n] = *(const f32x4*)(cs + col0 + bj * HALF + 4 * n); w[bj][n] = *(const f32x4*)(bw + col0 + bj * HALF + 4 * n); }
        float mu[8], rs[8];
#pragma unroll
        for (int r = 0; r < 8; ++r) row_stats(st, row0 + (r >> 2) * HALF + (r & 3) * 16, mu[r], rs[r]);
#pragma unroll
        for (int ai = 0; ai < 2; ++ai)
#pragma unroll
            for (int m = 0; m < 4; ++m) { const int row = row0 + ai * HALF + m * 16; const float mean = mu[ai * 4 + m], rstd = rs[ai * 4 + m];
                bf16_t* rowp = O + (size_t)row * LDC + col0;
#pragma unroll
                for (int bj = 0; bj < 2; ++bj) { f32x4 v0 = (acc[ai][bj][m][0] - c[bj][0] * mean) * rstd + w[bj][0], v1 = (acc[ai][bj][m][1] - c[bj][1] * mean) * rstd + w[bj][1];
                    if (ACT == 2) {
#pragma unroll
                        for (int j = 0; j < 4; ++j) { float a = fmaxf(v0[j], 0.f), b = fmaxf(v1[j], 0.f); v0[j] = a * a; v1[j] = b * b; } }
                    u32x4 pw; pw.x = cvt_pk_bf16(v0[0], v0[1]); pw.y = cvt_pk_bf16(v0[2], v0[3]); pw.z = cvt_pk_bf16(v1[0], v1[1]); pw.w = cvt_pk_bf16(v1[2], v1[3]);
                    *(u32x4*)(rowp + bj * HALF) = pw; } }
    }
};
template <bool OUTB> struct EpiResidLn2 {
    static constexpr bool PERM = true, AFTER_DRAIN = false;
    const float* Src; float* Dst; bf16_t* YB; const float* st_in; const float* gam; const float* bet; float* st_out;
    static constexpr int ldc = 2048; static constexpr float alpha = 1.4142135623730951f;
    __device__ __forceinline__ void operator()(const f32x4 (&acc)[2][2][4][2], const Unit& u, int wr, int wc, int fr, int fq) const {
        typedef float f32x2v __attribute__((ext_vector_type(2)));
        const int row0 = u.pm * BM + wr * 64 + fr; const int col0 = u.pn * BM + wc * 32 + 8 * fq;
        f32x4 g[2][2], b[2][2];
#pragma unroll
        for (int bj = 0; bj < 2; ++bj)
#pragma unroll
            for (int n = 0; n < 2; ++n) { g[bj][n] = *(const f32x4*)(gam + col0 + bj * HALF + 4 * n); b[bj][n] = *(const f32x4*)(bet + col0 + bj * HALF + 4 * n) * alpha; }
        f32x4 nx[2][2]; f32x2v nst;
        { const int row = row0; nst = *(const f32x2v*)(st_in + 2 * row);
#pragma unroll
          for (int bj = 0; bj < 2; ++bj) { const size_t off = (size_t)row * ldc + col0 + bj * HALF; nx[bj][0] = *(const f32x4*)(Src + off); nx[bj][1] = *(const f32x4*)(Src + off + 4); } }
#pragma unroll
        for (int r = 0; r < 8; ++r) { const int ai = r >> 2, m = r & 3; const int row = row0 + ai * HALF + m * 16;
            f32x4 cx[2][2]; const f32x2v cst = nst;
#pragma unroll
            for (int bj = 0; bj < 2; ++bj) { cx[bj][0] = nx[bj][0]; cx[bj][1] = nx[bj][1]; }
            if (r + 1 < 8) { const int rown = row0 + ((r + 1) >> 2) * HALF + ((r + 1) & 3) * 16; nst = *(const f32x2v*)(st_in + 2 * rown);
#pragma unroll
                for (int bj = 0; bj < 2; ++bj) { const size_t off = (size_t)rown * ldc + col0 + bj * HALF; nx[bj][0] = *(const f32x4*)(Src + off); nx[bj][1] = *(const f32x4*)(Src + off + 4); } }
            const float mean = cst.x * (1.0f / 2048.0f); const float rstd = 1.0f / sqrtf(cst.y * (1.0f / 2048.0f) - mean * mean + 1e-5f);
            const float sc = rstd * alpha; float s1 = 0.f, s2 = 0.f;
#pragma unroll
            for (int bj = 0; bj < 2; ++bj) { const size_t off = (size_t)row * ldc + col0 + bj * HALF;
                const f32x4 a = (cx[bj][0] - mean) * sc * g[bj][0] + b[bj][0] + acc[ai][bj][m][0], d = (cx[bj][1] - mean) * sc * g[bj][1] + b[bj][1] + acc[ai][bj][m][1];
                *(f32x4*)(Dst + off) = a; *(f32x4*)(Dst + off + 4) = d;
                if (OUTB) { u32x4 pw; pw.x = cvt_pk_bf16(a[0], a[1]); pw.y = cvt_pk_bf16(a[2], a[3]); pw.z = cvt_pk_bf16(d[0], d[1]); pw.w = cvt_pk_bf16(d[2], d[3]);
                    *(u32x4*)(YB + off) = pw;
                    s1 += ((a[0] + a[1]) + (a[2] + a[3])) + ((d[0] + d[1]) + (d[2] + d[3]));
                    s2 += ((a[0] * a[0] + a[1] * a[1]) + (a[2] * a[2] + a[3] * a[3])) + ((d[0] * d[0] + d[1] * d[1]) + (d[2] * d[2] + d[3] * d[3])); } }
            if (OUTB) { s1 += __shfl_xor(s1, 16); s2 += __shfl_xor(s2, 16); s1 += __shfl_xor(s1, 32); s2 += __shfl_xor(s2, 32);
                if (fq == 0) { __hip_atomic_fetch_add(st_out + 2 * row, s1, __ATOMIC_RELAXED, __HIP_MEMORY_SCOPE_AGENT); __hip_atomic_fetch_add(st_out + 2 * row + 1, s2, __ATOMIC_RELAXED, __HIP_MEMORY_SCOPE_AGENT); } } }
    }
};

template <class Epi, class Sched, bool ALIGN_EPI = false, bool SP2 = false>
__device__ __forceinline__ void gemm_phase(PG8_LAS unsigned char* lds, const Gemm g, const Sched& S, const Epi& E) {
    const int tid = threadIdx.x, wid = __builtin_amdgcn_readfirstlane(tid >> 6), lane = tid & 63, wr = wid >> 2, wc = wid & 3, fr = lane & 15, fq = lane >> 4;
    const int K = g.K, nt = K / BK;
    unsigned voffA[2], voffB[2];
#pragma unroll
    for (int i = 0; i < 2; ++i) { int R, C; stage_rc(tid * 16 + i * 8192, R, C); const int Rb = Epi::PERM ? ((R & ~31) + perm32(R & 31)) : R;
        voffA[i] = (unsigned)(R * K + C) * 2u; voffB[i] = (unsigned)(Rb * K + C) * 2u; }
    const size_t kstep = (size_t)(BK * 2);
    const size_t hstep = (size_t)HALF * K * 2;
    const size_t tstep = 2 * hstep;
    const unsigned ldsw = (unsigned)wid * 1024u;
    const int aoff = lds_byte(wr * 64 + fr, fq * 8), boff = lds_byte(wc * 32 + fr, fq * 8);
#define PG8_SA(b, h) (((b) * 2 + (h)) * HTB)
#define PG8_SB(b, h) ((4 + (b) * 2 + (h)) * HTB)
#define PG8_STAGE(bufoff, gbase, voff) do { _Pragma("unroll") for (int _i = 0; _i < 2; ++_i) \
        __builtin_amdgcn_global_load_lds((const unsigned*)((const char*)(gbase) + (voff)[_i]), (PG8_LAS unsigned*)(lds + (bufoff) + ldsw + _i * 8192), 16, 0, 0); } while (0)
#define PG8_LDA(dst, b, h) do { _Pragma("unroll") for (int m = 0; m < 4; ++m) _Pragma("unroll") for (int k = 0; k < 2; ++k) dst[m][k] = *(const PG8_LAS bf16x8*)(lds + PG8_SA(b, h) + aoff + m * 2048 + k * 1024); } while (0)
#define PG8_LDB(dst, b, h) do { _Pragma("unroll") for (int n = 0; n < 2; ++n) _Pragma("unroll") for (int k = 0; k < 2; ++k) dst[n][k] = *(const PG8_LAS bf16x8*)(lds + PG8_SB(b, h) + boff + n * 2048 + k * 1024); } while (0)
#define PG8_MMA(ai, bj, At, Bt) do { __builtin_amdgcn_s_setprio(1); _Pragma("unroll") for (int m = 0; m < 4; ++m) _Pragma("unroll") for (int n = 0; n < 2; ++n) _Pragma("unroll") for (int k = 0; k < 2; ++k) \
        acc[ai][bj][m][n] = __builtin_amdgcn_mfma_f32_16x16x32_bf16(Bt[n][k], At[m][k], acc[ai][bj][m][n], 0, 0, 0); __builtin_amdgcn_s_setprio(0); } while (0)
#define PG8_WAIT_V(n) asm volatile("s_waitcnt vmcnt(" #n ")" ::: "memory")
#define PG8_WAIT_L(n) asm volatile("s_waitcnt lgkmcnt(" #n ")" ::: "memory")
#define PG8_BAR __builtin_amdgcn_s_barrier()
#define PG8_SCHED __builtin_amdgcn_sched_barrier(0)
    Unit cur, nxt; int ui = 0;
    if (!S.next(0, cur)) return;
    f32x4 acc[2][2][4][2];
#pragma unroll
    for (int a = 0; a < 2; ++a)
#pragma unroll
        for (int b = 0; b < 2; ++b)
#pragma unroll
            for (int m = 0; m < 4; ++m)
#pragma unroll
                for (int n = 0; n < 2; ++n) acc[a][b][m][n] = (f32x4){0.f, 0.f, 0.f, 0.f};
    bf16x8 At[4][2], B0[2][2], B1[2][2];
    const char* cA = (const char*)g.A + (size_t)cur.pm * tstep; const char* cB = (const char*)g.Bt + (size_t)cur.pn * tstep;
    S.a_ready(cur);
    if constexpr (SP2) {
        PG8_STAGE(PG8_SB(0, 0), cB, voffB); PG8_STAGE(PG8_SB(0, 1), cB + hstep, voffB); PG8_STAGE(PG8_SA(0, 0), cA, voffA); PG8_STAGE(PG8_SA(0, 1), cA + hstep, voffA);
        if (wr == 1) PG8_BAR;
        PG8_WAIT_V(2); PG8_BAR;
        PG8_STAGE(PG8_SB(1, 0), cB + kstep, voffB); PG8_STAGE(PG8_SA(1, 0), cA + kstep, voffA); PG8_STAGE(PG8_SB(1, 1), cB + hstep + kstep, voffB);
        PG8_WAIT_V(6); PG8_BAR;
    } else {
        PG8_STAGE(PG8_SB(0, 0), cB, voffB); PG8_STAGE(PG8_SA(0, 0), cA, voffA); PG8_STAGE(PG8_SB(0, 1), cB + hstep, voffB); PG8_STAGE(PG8_SA(0, 1), cA + hstep, voffA);
        if (wr == 1) PG8_BAR;
        PG8_WAIT_V(4); PG8_BAR;
        PG8_STAGE(PG8_SB(1, 0), cB + kstep, voffB); PG8_STAGE(PG8_SA(1, 0), cA + kstep, voffA); PG8_STAGE(PG8_SB(1, 1), cB + hstep + kstep, voffB);
        PG8_WAIT_V(6); PG8_BAR;
    }
    for (;;) {
        const bool has_next = S.next(ui + 1, nxt);
        const char* nA = has_next ? (const char*)g.A + (size_t)nxt.pm * tstep : cA; const char* nB = has_next ? (const char*)g.Bt + (size_t)nxt.pn * tstep : cB;
        for (int t = 0; t < nt; t += 2) {
            const bool last = (t == nt - 2);
            const char* a1 = cA + (size_t)(t + 1) * kstep;
            const char* a2 = last ? nA : cA + (size_t)(t + 2) * kstep; const char* b2 = last ? nB : cB + (size_t)(t + 2) * kstep;
            const char* a3 = a2 + kstep; const char* b3 = b2 + kstep;
            if (last && has_next) S.a_ready(nxt);
            if constexpr (SP2) {
            PG8_LDB(B0, 0, 0); PG8_LDB(B1, 0, 1); PG8_SCHED; PG8_LDA(At, 0, 0); PG8_STAGE(PG8_SA(1, 1), a1 + hstep, voffA);
            PG8_WAIT_V(8); PG8_WAIT_L(0); PG8_BAR; PG8_MMA(0, 0, At, B0); PG8_MMA(0, 1, At, B1); PG8_BAR; PG8_SCHED;
            PG8_LDA(At, 0, 1); PG8_STAGE(PG8_SB(0, 0), b2, voffB); PG8_STAGE(PG8_SB(0, 1), b2 + hstep, voffB); PG8_STAGE(PG8_SA(0, 0), a2, voffA);
            PG8_WAIT_V(8); PG8_WAIT_L(0); PG8_BAR; PG8_MMA(1, 0, At, B0); PG8_MMA(1, 1, At, B1); PG8_BAR; PG8_SCHED;
            PG8_LDB(B0, 1, 0); PG8_LDB(B1, 1, 1); PG8_SCHED; PG8_LDA(At, 1, 0); PG8_STAGE(PG8_SA(0, 1), a2 + hstep, voffA);
            PG8_WAIT_V(8); PG8_WAIT_L(0); PG8_BAR; PG8_MMA(0, 0, At, B0); PG8_MMA(0, 1, At, B1); PG8_BAR; PG8_SCHED;
            PG8_LDA(At, 1, 1); PG8_STAGE(PG8_SB(1, 0), b3, voffB); PG8_STAGE(PG8_SB(1, 1), b3 + hstep, voffB); PG8_STAGE(PG8_SA(1, 0), a3, voffA);
            PG8_WAIT_V(8); PG8_WAIT_L(0); PG8_BAR; PG8_MMA(1, 0, At, B0); PG8_MMA(1, 1, At, B1); PG8_BAR; PG8_SCHED;
            } else {
            PG8_LDB(B0, 0, 0); PG8_SCHED; PG8_LDA(At, 0, 0); PG8_STAGE(PG8_SA(1, 1), a1 + hstep, voffA);
            PG8_WAIT_L(8); PG8_BAR; PG8_WAIT_L(0); PG8_MMA(0, 0, At, B0); PG8_BAR; PG8_SCHED;
            PG8_LDB(B1, 0, 1); PG8_STAGE(PG8_SB(0, 0), b2, voffB);
            PG8_BAR; PG8_WAIT_L(0); PG8_MMA(0, 1, At, B1); PG8_BAR;
            PG8_LDA(At, 0, 1); PG8_STAGE(PG8_SA(0, 0), a2, voffA);
            PG8_BAR; PG8_WAIT_L(0); PG8_MMA(1, 0, At, B0); PG8_BAR; PG8_SCHED;
            PG8_STAGE(PG8_SB(0, 1), b2 + hstep, voffB);
            PG8_WAIT_V(6); PG8_BAR; PG8_MMA(1, 1, At, B1); PG8_BAR;
            PG8_LDB(B0, 1, 0); PG8_SCHED; PG8_LDA(At, 1, 0); PG8_STAGE(PG8_SA(0, 1), a2 + hstep, voffA);
            PG8_WAIT_L(8); PG8_BAR; PG8_WAIT_L(0); PG8_MMA(0, 0, At, B0); PG8_BAR; PG8_SCHED;
            PG8_LDB(B1, 1, 1); PG8_STAGE(PG8_SB(1, 0), b3, voffB);
            PG8_BAR; PG8_WAIT_L(0); PG8_MMA(0, 1, At, B1); PG8_BAR;
            PG8_LDA(At, 1, 1); PG8_STAGE(PG8_SA(1, 0), a3, voffA);
            PG8_BAR; PG8_WAIT_L(0); PG8_MMA(1, 0, At, B0); PG8_BAR; PG8_SCHED;
            PG8_STAGE(PG8_SB(1, 1), b3 + hstep, voffB);
            PG8_WAIT_V(6); PG8_BAR; PG8_MMA(1, 1, At, B1); PG8_BAR;
            }
        }
        if constexpr (ALIGN_EPI) { if (wr == 0) PG8_BAR; }
        if constexpr (!Epi::AFTER_DRAIN) { E(acc, cur, wr, wc, fr, fq); S.done(cur); }
        if (!has_next) break;
#pragma unroll
        for (int a = 0; a < 2; ++a)
#pragma unroll
            for (int b = 0; b < 2; ++b)
#pragma unroll
                for (int m = 0; m < 4; ++m)
#pragma unroll
                    for (int n = 0; n < 2; ++n) acc[a][b][m][n] = (f32x4){0.f, 0.f, 0.f, 0.f};
        cur = nxt; cA = nA; cB = nB; ++ui;
        if constexpr (ALIGN_EPI) { if (wr == 1) PG8_BAR; }
    }
    PG8_WAIT_V(0);
    if constexpr (!ALIGN_EPI) { if (wr == 0) PG8_BAR; }
    PG8_BAR;
    if constexpr (Epi::AFTER_DRAIN) { E.fused(acc, cur, wr, wc, fr, fq, lds, wid, lane); S.done(cur); }
#undef PG8_SA
#undef PG8_SB
#undef PG8_STAGE
#undef PG8_LDA
#undef PG8_LDB
#undef PG8_MMA
#undef PG8_WAIT_V
#undef PG8_WAIT_L
#undef PG8_BAR
#undef PG8_SCHED
}
}

#define LAS __attribute__((address_space(3)))
typedef unsigned short bf16_t;
typedef short bf16x8 __attribute__((ext_vector_type(8)));
typedef short s16x4 __attribute__((ext_vector_type(4)));
typedef float f32x4 __attribute__((ext_vector_type(4)));
typedef float f32x16 __attribute__((ext_vector_type(16)));
typedef unsigned u32x4 __attribute__((ext_vector_type(4)));
typedef unsigned u32x2 __attribute__((ext_vector_type(2)));

constexpr int DM = 2048, NB = 4, SEQ = 4096, MTOK = NB * SEQ, DEPTH = 2, HD = 128;
constexpr int INW = 6144, DFF = 8192;
constexpr float LN_EPS = 1e-5f, RMS_EPS = 1e-5f;
constexpr float ALPHA = 1.4142135623730951f;
constexpr float LOG2E = 1.4426950408889634f, LN2 = 0.6931471805599453f;
constexpr float QK_SCALE = 0.08838834764831845f;

constexpr size_t MiB = 1u << 20;
constexpr size_t WS_WIN = 2 * MiB, WS_WOUT = WS_WIN + 24 * MiB, WS_WUP = WS_WOUT + 8 * MiB, WS_WDN = WS_WUP + 32 * MiB;
constexpr size_t WS_HB = WS_WDN + 32 * MiB;
constexpr size_t WS_BIG = WS_HB + 64 * MiB;
constexpr size_t WS_QKV = WS_BIG, WS_MRG = WS_BIG + 192 * MiB, WS_U = WS_BIG;
constexpr size_t WS_END = WS_BIG + 256 * MiB;

constexpr int LDS_BYTES = 147456;
constexpr int LDS_TAB = 131072, LDS_FLAGS = 131072 + 1024;

__device__ __forceinline__ float wave_sum(float v) {
#pragma unroll
    for (int o = 32; o >= 1; o >>= 1) v += __shfl_xor(v, o);
    return v;
}
__device__ __forceinline__ unsigned pk2(float lo, float hi) { return pg8::cvt_pk_bf16(lo, hi); }

template <bool WF32, bool WB16>
__device__ __forceinline__ void ln_phase(const float* src, float* dstf, bf16_t* dstb, float* rs, const float* g, const float* bt) {
    const int lane = threadIdx.x & 63, wave = threadIdx.x >> 6; const int step = gridDim.x * 8;
    int row = blockIdx.x * 8 + wave; if (row >= MTOK) return;
    f32x4 gg[8], bb[8], nx[8];
#pragma unroll
    for (int i = 0; i < 8; ++i) { const int c = (i * 64 + lane) * 4; gg[i] = *(const f32x4*)(g + c); bb[i] = *(const f32x4*)(bt + c); nx[i] = *(const f32x4*)(src + (size_t)row * DM + c); }
    for (;;) {
        f32x4 v[8]; float s = 0.f; const int rown = row + step;
#pragma unroll
        for (int i = 0; i < 8; ++i) { v[i] = nx[i]; s += (v[i][0] + v[i][1]) + (v[i][2] + v[i][3]); }
        if (rown < MTOK) {
#pragma unroll
            for (int i = 0; i < 8; ++i) nx[i] = *(const f32x4*)(src + (size_t)rown * DM + (i * 64 + lane) * 4); }
        asm volatile("" ::: "memory");
        const float mean = wave_sum(s) * (1.0f / 2048.0f); float q = 0.f;
#pragma unroll
        for (int i = 0; i < 8; ++i) { v[i] = v[i] - mean; q += (v[i][0] * v[i][0] + v[i][1] * v[i][1]) + (v[i][2] * v[i][2] + v[i][3] * v[i][3]); }
        const float q0_ = wave_sum(q); const float rstd = 1.0f / sqrtf(q0_ * (1.0f / 2048.0f) + LN_EPS);
        if (WB16 && lane == 0) { const float sm = mean * 2048.0f; rs[2 * row] = sm; rs[2 * row + 1] = q0_ + mean * sm; }
#pragma unroll
        for (int i = 0; i < 8; ++i) { const int c = (i * 64 + lane) * 4; const f32x4 y = v[i] * rstd * gg[i] + bb[i];
            if (WF32) *(f32x4*)(dstf + (size_t)row * DM + c) = y;
            if (WB16) { u32x2 w; w.x = pk2(y[0], y[1]); w.y = pk2(y[2], y[3]); *(u32x2*)(dstb + (size_t)row * DM + c) = w; } }
        if (rown >= MTOK) break;
        row = rown;
    }
}

template <bool FOLD>
__device__ __forceinline__ void tconv_mat(const float* W, int K, int N, bf16_t* WT, const float* gam, const float* bet, float* cs, float* bw, LAS float* scr) {
    const int tkn = K / 64, tnn = N / 64, nt = tkn * tnn, tid = threadIdx.x;
    const int kk = tid >> 4, n4 = (tid & 15) * 4, n = tid >> 3, k8 = (tid & 7) * 8;
    int it = blockIdx.x; if (it >= nt) return;
    f32x4 v0, v1;
    { const int tk = it / tnn, tn = it % tnn; const float* p = W + (size_t)(tk * 64 + kk) * N + tn * 64 + n4; v0 = *(const f32x4*)p; v1 = *(const f32x4*)(p + (size_t)32 * N); }
    for (;;) {
        const int tk = it / tnn, tn = it % tnn, nx = it + (int)gridDim.x;
        const f32x4 w0 = v0, w1 = v1;
        if (nx < nt) { const int tk2 = nx / tnn, tn2 = nx % tnn; const float* p = W + (size_t)(tk2 * 64 + kk) * N + tn2 * 64 + n4; v0 = *(const f32x4*)p; v1 = *(const f32x4*)(p + (size_t)32 * N); }
        scr[(n4 + 0) * 65 + kk] = w0[0]; scr[(n4 + 1) * 65 + kk] = w0[1]; scr[(n4 + 2) * 65 + kk] = w0[2]; scr[(n4 + 3) * 65 + kk] = w0[3];
        scr[(n4 + 0) * 65 + kk + 32] = w1[0]; scr[(n4 + 1) * 65 + kk + 32] = w1[1]; scr[(n4 + 2) * 65 + kk + 32] = w1[2]; scr[(n4 + 3) * 65 + kk + 32] = w1[3];
        __syncthreads();
        { float x[8]; float bsum = 0.f, csum = 0.f;
          if (FOLD) { const f32x4 g0 = *(const f32x4*)(gam + tk * 64 + k8), g1 = *(const f32x4*)(gam + tk * 64 + k8 + 4), b0 = *(const f32x4*)(bet + tk * 64 + k8), b1 = *(const f32x4*)(bet + tk * 64 + k8 + 4);
#pragma unroll
              for (int j = 0; j < 8; ++j) { const float xv = scr[n * 65 + k8 + j]; bsum += xv * (j < 4 ? b0[j & 3] : b1[j & 3]); x[j] = xv * (j < 4 ? g0[j & 3] : g1[j & 3]); }
          } else {
#pragma unroll
              for (int j = 0; j < 8; ++j) x[j] = scr[n * 65 + k8 + j]; }
          u32x4 w; w.x = pk2(x[0], x[1]); w.y = pk2(x[2], x[3]); w.z = pk2(x[4], x[5]); w.w = pk2(x[6], x[7]);
          *(u32x4*)(WT + (size_t)(tn * 64 + n) * K + tk * 64 + k8) = w;
          if (FOLD) {
#pragma unroll
              for (int c = 0; c < 4; ++c) csum += __uint_as_float(w[c] << 16) + __uint_as_float(w[c] & 0xffff0000u);
              csum += __shfl_xor(csum, 1); bsum += __shfl_xor(bsum, 1); csum += __shfl_xor(csum, 2); bsum += __shfl_xor(bsum, 2); csum += __shfl_xor(csum, 4); bsum += __shfl_xor(bsum, 4);
              if ((tid & 7) == 0) { __hip_atomic_fetch_add(cs + tn * 64 + n, csum, __ATOMIC_RELAXED, __HIP_MEMORY_SCOPE_AGENT); __hip_atomic_fetch_add(bw + tn * 64 + n, bsum, __ATOMIC_RELAXED, __HIP_MEMORY_SCOPE_AGENT); } } }
        __syncthreads();
        if (nx >= nt) break;
        it = nx;
    }
}
__device__ __forceinline__ void tconv_matrix(const float* W, int K, int N, bf16_t* WT, LAS float* scr) { tconv_mat<false>(W, K, N, WT, nullptr, nullptr, nullptr, nullptr, scr); }
__device__ __forceinline__ void tconv_matrix_fold(const float* W, int K, int N, bf16_t* WT, const float* gam, const float* bet, float* cs, float* bw, LAS float* scr) { tconv_mat<true>(W, K, N, WT, gam, bet, cs, bw, scr); }

#define MFMA32(a, b, c) __builtin_amdgcn_mfma_f32_32x32x16_bf16((a), (b), (c), 0, 0, 0)
__device__ __forceinline__ int crow(int i, int hh) { return (i & 3) + 8 * (i >> 2) + 4 * hh; }
typedef short v4i16_t __attribute__((ext_vector_type(4)));
__device__ __forceinline__ s16x4 vtr(LAS const unsigned char* p) { return __builtin_bit_cast(s16x4, __builtin_amdgcn_ds_read_tr16_b64_v4i16((LAS v4i16_t*)p)); }
__device__ __forceinline__ int t5_bucket(int n) {
    if (n < 16) return n;
    int large = 16 + (int)(logf((float)n * (1.0f / 16.0f)) / 2.0794415416798357f * 16.0f);
    return large < 31 ? large : 31;
}

__device__ __forceinline__ void glds16(const void* gsrc, unsigned lds_dst) { unsigned keep;
    asm volatile("s_mov_b32 %0, m0\n\ts_mov_b32 m0, %2\n\ts_nop 0\n\tglobal_load_lds_dwordx4 %1, off\n\ts_mov_b32 m0, %0" : "=&s"(keep) : "v"(gsrc), "s"(lds_dst) : "memory"); }
template <bool SB>
__device__ __forceinline__ void attn_unit(LAS unsigned char* lds, const bf16_t* qkv, bf16_t* merged, int b, int gi, int qb,
                                          const float* gnorm, float lam, float outscale, const float* rel_bias) {
    constexpr int NDV = SB ? 4 : 8;
    int tid_ = threadIdx.x; asm volatile("" : "+v"(tid_));
    const int tid = tid_, lane = tid & 63, w = __builtin_amdgcn_readfirstlane(tid >> 6), g = w >> 2, sub = w & 3;
    const int r = lane & 31, hh = lane >> 5;
    const int qcol = (SB ? 0 : 3072) + gi * 256, kcol = qcol + 1024, vcol = qcol + 2048;
    const int q0 = qb * 128 + sub * 32, t = q0 + r;
    const size_t rowbase = (size_t)b * SEQ;
    LAS float* tab = (LAS float*)(lds + LDS_TAB);
    LAS int* flags = (LAS int*)(lds + LDS_FLAGS);

    bf16x8 qf[8];
    { const bf16_t* qp = qkv + (rowbase + t) * INW + qcol + g * 128 + 8 * hh;
#pragma unroll
      for (int s = 0; s < 8; ++s) qf[s] = *(const bf16x8*)(qp + 16 * s); }
    if (!SB) { if (tid < 129) tab[tid] = rel_bias[t5_bucket(tid) * 4 + gi] * LOG2E; }

    const int srow = w * 2 + hh;
    const int ck = (r & 16) | ((r & 15) ^ (srow & 15));
    const int cv = (((r >> 2) ^ (srow & 3)) << 2) | (r & 3);
    const size_t soffK = (size_t)srow * INW + kcol + ck * 8, soffV = (size_t)srow * INW + vcol + cv * 8;
    const unsigned kbase = (unsigned)(r * 512 + g * 256 + ((hh ^ (r & 15)) << 4));
    const int i16 = lane & 15, tq = i16 >> 2, tp = i16 & 3, tG = (lane >> 4) & 1;
    const unsigned vq = (unsigned)((4 * hh + tq) * 512 + 32 * tG + 8 * tp + (tq << 6)) + 32768u;

    f32x16 O[NDV];
#pragma unroll
    for (int d = 0; d < NDV; ++d)
#pragma unroll
        for (int i = 0; i < 16; ++i) O[d][i] = 0.f;
    float m = -1e30f, l = 0.f, carry = 0.f;
    bool wdone = false;

    const int ktmax = 2 * qb + 1;
    const unsigned ldsb = (unsigned)(size_t)lds;
#define ISSUE_STAGE(KT, ST) do { const bf16_t* gb_ = qkv + (rowbase + (size_t)(KT) * 64) * INW; \
        _Pragma("unroll") for (int i_ = 0; i_ < 4; ++i_) { \
            glds16(gb_ + soffK + (size_t)i_ * 16 * INW, (unsigned)__builtin_amdgcn_readfirstlane((int)(ldsb + (ST) * 65536 + i_ * 8192 + w * 1024))); \
            glds16(gb_ + soffV + (size_t)i_ * 16 * INW, (unsigned)__builtin_amdgcn_readfirstlane((int)(ldsb + (ST) * 65536 + 32768 + i_ * 8192 + w * 1024))); } } while (0)

    int kt = ktmax, st = 0;
    ISSUE_STAGE(kt, 0);
    for (;;) {
        asm volatile("s_waitcnt vmcnt(0)" ::: "memory");
        __syncthreads();
        if (SB && kt != ktmax) { const int f = flags[(st ^ 1) * 8 + (lane & 7)]; if (__all(f != 0)) break; }
        if (kt > 0) ISSUE_STAGE(kt - 1, st ^ 1);
        LAS const unsigned char* stage = lds + st * 65536;
#pragma unroll
        for (int kbi = 0; kbi < 2; ++kbi) {
            const int kb = 1 - kbi;
            const int s0 = 64 * kt + 32 * kb;
            const bool skip = SB ? (s0 >= q0 + 31 || wdone) : (s0 > q0 + 31);
            if (!skip) {
                f32x16 sacc;
#pragma unroll
                for (int i = 0; i < 16; ++i) sacc[i] = 0.f;
#pragma unroll
                for (int s = 0; s < 8; ++s) { const bf16x8 kf = *(LAS const bf16x8*)(stage + ((kbase ^ (unsigned)(s << 5)) + kb * 16384)); sacc = MFMA32(kf, qf[s], sacc); }
                float p[16];
                if (SB) {
                    float z[16], lf[16];
#pragma unroll
                    for (int i = 0; i < 16; ++i) { const float zz = sacc[i] * QK_SCALE; const bool valid = (s0 + crow(i, hh)) < t;
                        const float e = __builtin_amdgcn_exp2f(-fabsf(zz) * LOG2E);
                        const float sp = fmaxf(zz, 0.f) + LN2 * __builtin_amdgcn_logf(1.0f + e);
                        lf[i] = valid ? -sp : 0.f; z[i] = zz; }
                    float gs[4], pg[4];
#pragma unroll
                    for (int q4 = 0; q4 < 4; ++q4) { gs[q4] = (lf[4 * q4] + lf[4 * q4 + 1]) + (lf[4 * q4 + 2] + lf[4 * q4 + 3]); pg[q4] = __shfl_xor(gs[q4], 32); }
                    float run = carry;
#pragma unroll
                    for (int q4 = 3; q4 >= 0; --q4) {
                        const float base = run + (hh == 0 ? pg[q4] : 0.f);
                        const float s3 = base, s2 = s3 + lf[4 * q4 + 3], s1 = s2 + lf[4 * q4 + 2], s0f = s1 + lf[4 * q4 + 1];
                        const float sf[4] = {s0f, s1, s2, s3};
#pragma unroll
                        for (int j = 0; j < 4; ++j) { const int i = 4 * q4 + j; const bool valid = (s0 + crow(i, hh)) < t;
                            const float wv = __builtin_amdgcn_exp2f((z[i] + lf[i] + sf[j]) * LOG2E); p[i] = valid ? wv : 0.f; }
                        run += gs[q4] + pg[q4];
                    }
                    carry = run;
                } else {
                    float tv[16];
                    constexpr float C = QK_SCALE * LOG2E;
                    if (s0 + 31 + 128 <= q0) { const float cb = tab[128];
#pragma unroll
                        for (int i = 0; i < 16; ++i) tv[i] = sacc[i] * C + cb;
                    } else {
                        const unsigned tabb = (unsigned)(size_t)tab;
#pragma unroll
                        for (int q4 = 0; q4 < 4; ++q4) { const int d0 = t - (s0 + crow(4 * q4, hh));
                            unsigned a[4]; float bq[4];
#pragma unroll
                            for (int j = 0; j < 4; ++j) { const int dist = d0 - j; a[j] = tabb + 4u * (unsigned)(dist < 0 ? 0 : (dist > 128 ? 128 : dist)); }
                            asm volatile("ds_read_b32 %0, %4\n\tds_read_b32 %1, %5\n\tds_read_b32 %2, %6\n\tds_read_b32 %3, %7\n\ts_waitcnt lgkmcnt(0)"
                                         : "=&v"(bq[0]), "=&v"(bq[1]), "=&v"(bq[2]), "=&v"(bq[3]) : "v"(a[0]), "v"(a[1]), "v"(a[2]), "v"(a[3]) : "memory");
#pragma unroll
                            for (int j = 0; j < 4; ++j) tv[4 * q4 + j] = (d0 - j) >= 0 ? sacc[4 * q4 + j] * C + bq[j] : -1e30f; }
                    }
                    float mx = tv[0];
#pragma unroll
                    for (int i = 1; i < 16; ++i) mx = fmaxf(mx, tv[i]);
                    mx = fmaxf(mx, __shfl_xor(mx, 32));
                    if (__any(mx > m + 8.0f)) { const float mn = fmaxf(m, mx); const float corr = __builtin_amdgcn_exp2f(m - mn); m = mn; l *= corr;
#pragma unroll
                        for (int d = 0; d < NDV; ++d)
#pragma unroll
                            for (int i = 0; i < 16; ++i) O[d][i] *= corr; }
                    float ps = 0.f;
#pragma unroll
                    for (int i = 0; i < 16; ++i) { p[i] = __builtin_amdgcn_exp2f(tv[i] - m); ps += p[i]; }
                    l += ps;
                }
                bf16x8 pf[2];
#pragma unroll
                for (int s = 0; s < 2; ++s) { u32x4 pw; pw.x = pk2(p[8 * s + 0], p[8 * s + 1]); pw.y = pk2(p[8 * s + 2], p[8 * s + 3]); pw.z = pk2(p[8 * s + 4], p[8 * s + 5]); pw.w = pk2(p[8 * s + 6], p[8 * s + 7]);
                    pf[s] = __builtin_bit_cast(bf16x8, pw); }
#pragma unroll
                for (int d = 0; d < NDV; ++d) { const int dg = SB ? g * 4 + d : d; const unsigned va = vq ^ (unsigned)(dg << 6);
#pragma unroll
                    for (int s = 0; s < 2; ++s) {
                        const s16x4 lo = vtr(stage + va + (kb * 32 + 16 * s) * 512), hi = vtr(stage + va + (kb * 32 + 16 * s + 8) * 512);
                        const bf16x8 vf = __builtin_shufflevector(lo, hi, 0, 1, 2, 3, 4, 5, 6, 7);
                        O[d] = MFMA32(vf, pf[s], O[d]); } }
            }
        }
        if (SB) { wdone = __all(carry < -100.0f); if (lane == 0) flags[st * 8 + w] = wdone ? 1 : 0; }
        if (kt == 0) break;
        --kt; st ^= 1;
    }
#undef ISSUE_STAGE
    __syncthreads();
    if (SB) {
        float ss = 0.f;
#pragma unroll
        for (int d = 0; d < NDV; ++d)
#pragma unroll
            for (int i = 0; i < 16; ++i) ss += O[d][i] * O[d][i];
        ss += __shfl_xor(ss, 32);
        const float rstd = 1.0f / sqrtf(ss * (1.0f / 128.0f) + RMS_EPS);
        bf16_t* op = merged + (rowbase + t) * DM + gi * 256 + g * 128 + 4 * hh;
#pragma unroll
        for (int d = 0; d < NDV; ++d)
#pragma unroll
            for (int q4 = 0; q4 < 4; ++q4) { const int dv = d * 32 + 8 * q4; const f32x4 gg = *(const f32x4*)(gnorm + dv + 4 * hh);
                u32x2 o; o.x = pk2(O[d][4 * q4] * rstd * gg[0], O[d][4 * q4 + 1] * rstd * gg[1]); o.y = pk2(O[d][4 * q4 + 2] * rstd * gg[2], O[d][4 * q4 + 3] * rstd * gg[3]);
                *(u32x2*)(op + dv) = o; }
    } else {
        const float lt = l + __shfl_xor(l, 32);
        LAS float* ex = (LAS float*)lds + (size_t)sub * (NDV * 16 * 64) + lane;
        if (g == 1) { const float sc = lam / lt;
#pragma unroll
            for (int d = 0; d < NDV; ++d)
#pragma unroll
                for (int i = 0; i < 16; ++i) ex[(d * 16 + i) * 64] = O[d][i] * sc; }
        __syncthreads();
        if (g == 0) { const float sc = 1.0f / lt; float ss = 0.f;
#pragma unroll
            for (int d = 0; d < NDV; ++d)
#pragma unroll
                for (int i = 0; i < 16; ++i) { const float x = O[d][i] * sc - ex[(d * 16 + i) * 64]; O[d][i] = x; ss += x * x; }
            ss += __shfl_xor(ss, 32);
            const float rstd = outscale / sqrtf(ss * (1.0f / 256.0f) + RMS_EPS);
            bf16_t* op = merged + (rowbase + t) * DM + 1024 + gi * 256 + 4 * hh;
#pragma unroll
            for (int d = 0; d < NDV; ++d)
#pragma unroll
                for (int q4 = 0; q4 < 4; ++q4) { const int dv = d * 32 + 8 * q4; const f32x4 gg = *(const f32x4*)(gnorm + dv + 4 * hh);
                    u32x2 o; o.x = pk2(O[d][4 * q4] * rstd * gg[0], O[d][4 * q4 + 1] * rstd * gg[1]); o.y = pk2(O[d][4 * q4 + 2] * rstd * gg[2], O[d][4 * q4 + 3] * rstd * gg[3]);
                    *(u32x2*)(op + dv) = o; } }
    }
    __syncthreads();
}


#define XB_TMO      128
#define XB_XCNT(j)  (256  + 64 * (j))
#define XB_XSUB(j)  (1280 + 64 * (j))
#define XB_XGEN(j)  (2304 + 64 * (j))
#define XB_TOP      3328
#define XB_TOPGEN   3392
#define XCD_BAR_WORDS 3456
#define XB_SPIN_CAP (1u << 18)
__device__ __forceinline__ unsigned xb_ld(unsigned* p)              { return __hip_atomic_load(p, __ATOMIC_RELAXED, __HIP_MEMORY_SCOPE_AGENT); }
__device__ __forceinline__ unsigned xb_add(unsigned* p, unsigned v) { return __hip_atomic_fetch_add(p, v, __ATOMIC_RELAXED, __HIP_MEMORY_SCOPE_AGENT); }
__device__ __forceinline__ unsigned xb_xcc_id() { return (unsigned)__builtin_amdgcn_s_getreg((3 << 11) | 20) & 0xFu; }
#define XB_SPIN(cond, bar) do { unsigned _sp = 0; while (cond) { __builtin_amdgcn_s_sleep(1); \
    if ((++_sp & 255u) == 0u) { if (xb_ld(&(bar)[XB_TMO])) break; if (_sp > XB_SPIN_CAP) { atomicAdd(&(bar)[XB_TMO], 1u); break; } } } } while (0)
__device__ __forceinline__ void xcd_barrier_complete(unsigned* bar, unsigned x, unsigned& nloc, unsigned& nx) {
    const unsigned G = gridDim.x * gridDim.y * gridDim.z;
    unsigned sum, cnt, mine, sp = 0u;
    for (;;) {
        sum = 0u; cnt = 0u; mine = 0u;
#pragma unroll
        for (unsigned j = 0; j < 16; ++j) { const unsigned c = xb_ld(&bar[XB_XCNT(j)]); sum += c; cnt += (c > 0u) ? 1u : 0u; mine = (j == x) ? c : mine; }
        if (sum == G) break;
        __builtin_amdgcn_s_sleep(1);
        if ((++sp & 255u) == 0u) { if (xb_ld(&bar[XB_TMO])) break; if (sp > XB_SPIN_CAP) { atomicAdd(&bar[XB_TMO], 1u); break; } }
    }
    nloc = mine > 0u ? mine : 1u; nx = cnt > 0u ? cnt : 1u;
}
__device__ __forceinline__ void xcd_barrier(unsigned* bar, volatile LAS unsigned* st) {
    asm volatile("s_waitcnt vmcnt(0)" ::: "memory");
    __syncthreads();
    if (threadIdx.x == 0) {
        __builtin_amdgcn_s_waitcnt(0);
        const unsigned x = xb_xcc_id();
        unsigned nloc = st[0], nx = st[1];
        if (nloc == 0u) { xcd_barrier_complete(bar, x, nloc, nx); st[0] = nloc; st[1] = nx; }
        const unsigned old = xb_add(&bar[XB_XSUB(x)], 1u);
        const unsigned gen = old / nloc;
        if (old + 1u == (gen + 1u) * nloc) {
            __builtin_amdgcn_fence(__ATOMIC_RELEASE, "agent");
            asm volatile("s_waitcnt vmcnt(0)" ::: "memory");
            const unsigned og = xb_add(&bar[XB_TOP], 1u);
            const unsigned tg = og / nx;
            if (og + 1u == (tg + 1u) * nx) xb_add(&bar[XB_TOPGEN], 1u);
            else XB_SPIN(xb_ld(&bar[XB_TOPGEN]) == tg, bar);
            __builtin_amdgcn_fence(__ATOMIC_ACQUIRE, "agent");
            xb_add(&bar[XB_XGEN(x)], 1u);
            asm volatile("s_waitcnt vmcnt(0)" ::: "memory");
        } else {
            XB_SPIN(xb_ld(&bar[XB_XGEN(x)]) == gen, bar);
            __builtin_amdgcn_fence(__ATOMIC_ACQUIRE, "agent");
            asm volatile("s_waitcnt vmcnt(0)" ::: "memory");
        }
    }
    __syncthreads();
}

struct Args { const float* in[18]; float* out; unsigned char* ws; int ph_lo, ph_hi; };

typedef const Args __attribute__((address_space(4))) CArgs;
__device__ __forceinline__ CArgs* kargs() { CArgs* p = (CArgs*)__builtin_amdgcn_kernarg_segment_ptr(); asm volatile("" : "+s"(p)); return p; }
#define AIN(i) (kargs()->in[i])
__global__ void __launch_bounds__(512, 2) fwd_mega(Args a) {
    extern __shared__ __attribute__((aligned(16))) unsigned char lds_raw[];
    LAS unsigned char* lds = (LAS unsigned char*)lds_raw;
    cg::grid_group grid = cg::this_grid();
    unsigned char* ws = kargs()->ws;
    float* H = kargs()->out;
    bf16_t* HB = (bf16_t*)(ws + WS_HB);
    bf16_t* QKV = (bf16_t*)(ws + WS_QKV); bf16_t* MRG = (bf16_t*)(ws + WS_MRG); bf16_t* U = (bf16_t*)(ws + WS_U);
    const int lo = kargs()->ph_lo, hi = kargs()->ph_hi; const int G = gridDim.x, c = blockIdx.x;
    const int lane = threadIdx.x & 63;
    unsigned* BAR = (unsigned*)(ws + 1 * MiB);
    volatile LAS unsigned* BST = (volatile LAS unsigned*)(lds + LDS_FLAGS + 512);
    if (threadIdx.x == 0) { BST[0] = 0u; BST[1] = 0u; }
    __syncthreads();
#define IN(k) (lo <= (k) && (k) < hi)
#define SYNC(k) do { if (IN(k) && IN((k) + 1)) xcd_barrier(BAR, BST); } while (0)

#define ST(i) ((float*)ws + (size_t)(i) * MTOK * 2)
#define FOLDV(l, o) ((float*)(ws + 3 * MiB / 2) + (l) * 28672 + (o))
#define CSUP(l) FOLDV(l, 0)
#define BWUP(l) FOLDV(l, 8192)
#define CSIN(l) FOLDV(l, 16384)
#define BWIN(l) FOLDV(l, 22528)
    if (IN(0)) {
        ln_phase<false, true>(AIN(0), H, HB, ST(0), AIN(1), AIN(2));
        tconv_matrix(AIN(3), DM, INW, (bf16_t*)(ws + WS_WIN), (LAS float*)lds);
        tconv_matrix(AIN(4), DM, DM, (bf16_t*)(ws + WS_WOUT), (LAS float*)lds);
        tconv_matrix(AIN(15), DFF, DM, (bf16_t*)(ws + WS_WDN), (LAS float*)lds);
        { float* z1 = ST(1); for (int i = blockIdx.x * 512 + threadIdx.x; i < 3 * MTOK * 2; i += gridDim.x * 512) z1[i] = 0.f;
          float* z2 = FOLDV(0, 0); for (int i = blockIdx.x * 512 + threadIdx.x; i < 2 * 28672; i += gridDim.x * 512) z2[i] = 0.f;
          if (blockIdx.x == 0) for (int i = threadIdx.x; i < XCD_BAR_WORDS; i += 512) __hip_atomic_store(BAR + i, 0u, __ATOMIC_RELAXED, __HIP_MEMORY_SCOPE_AGENT); }
    }
    if (IN(0) && IN(1)) {
        grid.sync();
        if (threadIdx.x == 0) (void)xb_add(&BAR[XB_XCNT(xb_xcc_id())], 1u);
    }
    { constexpr int l = 0; constexpr int pb = 1;
        if (IN(pb + 0)) {
            pg8::Gemm g{HB, (const bf16_t*)(ws + WS_WIN), MTOK, INW, DM}; pg8::StaticOrder S; S.init(MTOK, INW, G, c);
            pg8::EpiBf16S<0> E{QKV, INW};
            pg8::gemm_phase<pg8::EpiBf16S<0>, pg8::StaticOrder, true, true>(lds, g, S, E);
            tconv_matrix_fold(AIN(14), DM, DFF, (bf16_t*)(ws + WS_WUP), AIN(12), AIN(13), CSUP(0), BWUP(0), (LAS float*)lds);
        }
        SYNC(pb + 0);
        if (IN(pb + 1)) {
            const float lam_init = (l == 0) ? 0.2f : 0.35550906759f;
            float d1 = AIN(6)[l * HD + lane] * AIN(7)[l * HD + lane] + AIN(6)[l * HD + 64 + lane] * AIN(7)[l * HD + 64 + lane];
            float d2 = AIN(8)[l * HD + lane] * AIN(9)[l * HD + lane] + AIN(8)[l * HD + 64 + lane] * AIN(9)[l * HD + 64 + lane];
            d1 = wave_sum(d1); d2 = wave_sum(d2);
            const float lam = __builtin_bit_cast(float, __builtin_amdgcn_readfirstlane(__builtin_bit_cast(int, expf(d1) - expf(d2) + lam_init)));
            const int vc = (G % 8 == 0) ? (c % 8) * (G / 8) + c / 8 : c;
            for (int it = vc; it < 256; it += G) {
                const int bh = it >> 4, j = it & 15;
#pragma unroll 1
                for (int k = 0; k < 2; ++k)
                    attn_unit<false>(lds, QKV, MRG, bh >> 2, bh & 3, k == 0 ? 31 - j : j, AIN(10) + l * 256, lam, 1.0f - lam_init, AIN(11));
            }
            for (int it = vc; it < 512; it += G) {
                const int bp = it >> 5, qb = it & 31;
                attn_unit<true>(lds, QKV, MRG, bp >> 2, bp & 3, qb, AIN(5) + l * HD, 0.f, 1.f, nullptr);
            }
        }
        SYNC(pb + 1);
        if (IN(pb + 2)) {
            pg8::Gemm g{MRG, (const bf16_t*)(ws + WS_WOUT), MTOK, DM, DM}; pg8::StaticOrder S; S.init(MTOK, DM, G, c);
            pg8::EpiResidLn2<true> E{AIN(0), H, HB, ST(0), AIN(1), AIN(2), ST(1)};
            pg8::gemm_phase<pg8::EpiResidLn2<true>, pg8::StaticOrder, true, true>(lds, g, S, E);
        }
        SYNC(pb + 2);
        if (IN(pb + 3)) {
            pg8::Gemm g{HB, (const bf16_t*)(ws + WS_WUP), MTOK, DFF, DM}; pg8::StaticOrder S; S.init(MTOK, DFF, G, c);
            pg8::EpiBf16Ln<2, DFF> E{U, ST(1), CSUP(0), BWUP(0)};
            pg8::gemm_phase<pg8::EpiBf16Ln<2, DFF>, pg8::StaticOrder, true, true>(lds, g, S, E);
        }
        SYNC(pb + 3);
        if (IN(pb + 4)) {
            pg8::Gemm g{U, (const bf16_t*)(ws + WS_WDN), MTOK, DM, DFF}; pg8::StaticOrder S; S.init(MTOK, DM, G, c);
            pg8::EpiResidLn2<true> E{H, H, HB, ST(1), AIN(12), AIN(13), ST(2)};
            pg8::gemm_phase<pg8::EpiResidLn2<true>, pg8::StaticOrder, true, true>(lds, g, S, E);
        }
        SYNC(pb + 4);
        if (IN(pb + 5)) {
            tconv_matrix_fold(AIN(3) + (size_t)DM * INW, DM, INW, (bf16_t*)(ws + WS_WIN), AIN(16), AIN(17), CSIN(1), BWIN(1), (LAS float*)lds);
            tconv_matrix(AIN(4) + (size_t)DM * DM, DM, DM, (bf16_t*)(ws + WS_WOUT), (LAS float*)lds);
            tconv_matrix_fold(AIN(14) + (size_t)DM * DFF, DM, DFF, (bf16_t*)(ws + WS_WUP), AIN(12) + DM, AIN(13) + DM, CSUP(1), BWUP(1), (LAS float*)lds);
            tconv_matrix(AIN(15) + (size_t)DFF * DM, DFF, DM, (bf16_t*)(ws + WS_WDN), (LAS float*)lds);
        }
        SYNC(pb + 5);
    }
    { constexpr int l = 1; constexpr int pb = 7;
        if (IN(pb + 0)) {
            pg8::Gemm g{HB, (const bf16_t*)(ws + WS_WIN), MTOK, INW, DM}; pg8::StaticOrder S; S.init(MTOK, INW, G, c);
            pg8::EpiBf16Ln<0, INW> E{QKV, ST(2), CSIN(1), BWIN(1)};
            pg8::gemm_phase<pg8::EpiBf16Ln<0, INW>, pg8::StaticOrder, true, true>(lds, g, S, E);
        }
        SYNC(pb + 0);
        if (IN(pb + 1)) {
            const float lam_init = (l == 0) ? 0.2f : 0.35550906759f;
            float d1 = AIN(6)[l * HD + lane] * AIN(7)[l * HD + lane] + AIN(6)[l * HD + 64 + lane] * AIN(7)[l * HD + 64 + lane];
            float d2 = AIN(8)[l * HD + lane] * AIN(9)[l * HD + lane] + AIN(8)[l * HD + 64 + lane] * AIN(9)[l * HD + 64 + lane];
            d1 = wave_sum(d1); d2 = wave_sum(d2);
            const float lam = __builtin_bit_cast(float, __builtin_amdgcn_readfirstlane(__builtin_bit_cast(int, expf(d1) - expf(d2) + lam_init)));
            const int vc = (G % 8 == 0) ? (c % 8) * (G / 8) + c / 8 : c;
            for (int it = vc; it < 256; it += G) {
                const int bh = it >> 4, j = it & 15;
#pragma unroll 1
                for (int k = 0; k < 2; ++k)
                    attn_unit<false>(lds, QKV, MRG, bh >> 2, bh & 3, k == 0 ? 31 - j : j, AIN(10) + l * 256, lam, 1.0f - lam_init, AIN(11));
            }
            for (int it = vc; it < 512; it += G) {
                const int bp = it >> 5, qb = it & 31;
                attn_unit<true>(lds, QKV, MRG, bp >> 2, bp & 3, qb, AIN(5) + l * HD, 0.f, 1.f, nullptr);
            }
        }
        SYNC(pb + 1);
        if (IN(pb + 2)) {
            pg8::Gemm g{MRG, (const bf16_t*)(ws + WS_WOUT), MTOK, DM, DM}; pg8::StaticOrder S; S.init(MTOK, DM, G, c);
            pg8::EpiResidLn2<true> E{H, H, HB, ST(2), AIN(16), AIN(17), ST(3)};
            pg8::gemm_phase<pg8::EpiResidLn2<true>, pg8::StaticOrder, true, true>(lds, g, S, E);
        }
        SYNC(pb + 2);
        if (IN(pb + 3)) {
            pg8::Gemm g{HB, (const bf16_t*)(ws + WS_WUP), MTOK, DFF, DM}; pg8::StaticOrder S; S.init(MTOK, DFF, G, c);
            pg8::EpiBf16Ln<2, DFF> E{U, ST(3), CSUP(1), BWUP(1)};
            pg8::gemm_phase<pg8::EpiBf16Ln<2, DFF>, pg8::StaticOrder, true, true>(lds, g, S, E);
        }
        SYNC(pb + 3);
        if (IN(pb + 4)) {
            pg8::Gemm g{U, (const bf16_t*)(ws + WS_WDN), MTOK, DM, DFF}; pg8::StaticOrder S; S.init(MTOK, DM, G, c);
            pg8::EpiResidLn2<false> E{H, H, HB, ST(3), AIN(12) + DM, AIN(13) + DM, ST(3)};
            pg8::gemm_phase<pg8::EpiResidLn2<false>, pg8::StaticOrder, true, true>(lds, g, S, E);
        }
        SYNC(pb + 4);
        if (IN(pb + 5)) ln_phase<true, false>(H, H, HB, ST(0), AIN(16) + DM, AIN(17) + DM);
        SYNC(pb + 5);
    }
#undef ST
#undef FOLDV
#undef CSUP
#undef BWUP
#undef CSIN
#undef BWIN
#undef IN
#undef SYNC
}

#ifndef MK_SPLIT
#define MK_SPLIT 0
#endif
extern "C" void kernel_launch(void* const* d_in, const int* in_sizes, int n_in, void* d_out, int out_size, void* d_ws, size_t ws_size, hipStream_t stream) {
    static int grid = 0;
    if (grid == 0) {
        if (n_in != 18 || out_size != MTOK * DM || ws_size < WS_END) { fprintf(stderr, "kernel_launch: unexpected shapes (n_in %d out %d ws %zu)\n", n_in, out_size, ws_size); grid = -1; return; }
        int dev = 0, cus = 0, per_cu = 0;
        hipGetDevice(&dev); hipDeviceGetAttribute(&cus, hipDeviceAttributeMultiprocessorCount, dev);
        if (hipFuncSetAttribute((const void*)fwd_mega, hipFuncAttributeMaxDynamicSharedMemorySize, LDS_BYTES) != hipSuccess) { fprintf(stderr, "kernel_launch: hipFuncSetAttribute failed\n"); grid = -1; return; }
        if (hipOccupancyMaxActiveBlocksPerMultiprocessor(&per_cu, (const void*)fwd_mega, 512, LDS_BYTES) != hipSuccess || per_cu < 1) { fprintf(stderr, "kernel_launch: occupancy query says %d\n", per_cu); per_cu = 1; }
        (void)hipGetLastError();
        grid = cus;
    }
    if (grid < 0) return;
    Args a{};
    for (int i = 0; i < 18; ++i) a.in[i] = (const float*)d_in[i];
    a.out = (float*)d_out; a.ws = (unsigned char*)d_ws;
    constexpr int NPH = 1 + 6 * DEPTH;
#if MK_SPLIT
    for (int p = 0; p < NPH; ++p) { a.ph_lo = p; a.ph_hi = p + 1; void* args[] = {&a};
        hipError_t e = hipLaunchCooperativeKernel((const void*)fwd_mega, dim3(grid), dim3(512), args, LDS_BYTES, stream);
        if (e != hipSuccess) { fprintf(stderr, "kernel_launch: cooperative launch failed: %s\n", hipGetErrorString(e)); break; } }
#else
    a.ph_lo = 0; a.ph_hi = NPH; void* args[] = {&a};
    hipError_t e = hipLaunchCooperativeKernel((const void*)fwd_mega, dim3(grid), dim3(512), args, LDS_BYTES, stream);
    if (e != hipSuccess) fprintf(stderr, "kernel_launch: cooperative launch failed: %s (grid %d)\n", hipGetErrorString(e), grid);
#endif
}
```
